# Optimizing an MI355X kernel written in HIP

```python
import math
import jax, jax.numpy as jnp
from jax import lax
import numpy as np

D_MODEL = 2048
BATCH = 2
SEQ = 4096
DEPTH = 4
DEC_BATCH = 8
DEC_SEQ = 2048
PAST_LEN = 128

HEAD_DIM = 64
V_DIM = 2 * HEAD_DIM
ATTN_WIDTH = D_MODEL // 2
N_HEADS = ATTN_WIDTH // V_DIM
FOURIER_WIDTH = D_MODEL - ATTN_WIDTH
N_FGROUPS = 4
FGROUP_DIM = FOURIER_WIDTH // N_FGROUPS
AB_IN_WIDTH = 3 * ATTN_WIDTH + FOURIER_WIDTH
CONV_DIM = D_MODEL
CONV_K = 3
D_FF = (11 * D_MODEL) // 4
NUM_BUCKETS = 32
MAX_DISTANCE = 128
Q_BLOCK = 128
N_AB_LAYERS = (DEPTH + 1) // 2
N_C_LAYERS = DEPTH // 2
EPS = 1e-6

kernel_name = "hybrid_diffattn_fnet_shortconv_encoder"


def rms_norm(x, g):
    xf = x.astype(jnp.float32)
    xf = xf * lax.rsqrt(jnp.mean(xf * xf, axis=-1, keepdims=True) + EPS)
    return (xf * g.astype(jnp.float32)).astype(x.dtype)


def dwconv3(x, w):
    xp = jnp.pad(x, ((0, 0), (1, 1), (0, 0)))
    return xp[:, :-2] * w[0] + xp[:, 1:-1] * w[1] + xp[:, 2:] * w[2]


def rel_bucket(rel):
    nb = NUM_BUCKETS // 2
    ret = jnp.where(rel > 0, nb, 0)
    n = jnp.abs(rel)
    max_exact = nb // 2
    nf = jnp.maximum(n, 1).astype(jnp.float32)
    large = max_exact + (jnp.log(nf / max_exact) / math.log(MAX_DISTANCE / max_exact)
                         * (nb - max_exact)).astype(jnp.int32)
    large = jnp.minimum(large, nb - 1)
    return ret + jnp.where(n < max_exact, n, large)


def lambda_init_fn(layer_idx):
    return 0.8 - 0.6 * math.exp(-0.3 * layer_idx)


def diff_attention(q, k, v, rel_bias, lam):
    B, S = q.shape[0], q.shape[1]
    nblk = S // Q_BLOCK
    qb = q.reshape(B, nblk, Q_BLOCK, N_HEADS, 2, HEAD_DIM).transpose(1, 0, 2, 3, 4, 5)
    starts = jnp.arange(nblk, dtype=jnp.int32) * Q_BLOCK
    kpos = jnp.arange(S, dtype=jnp.int32)
    scale = HEAD_DIM ** -0.5

    def one_block(args):
        qblk, start = args
        qpos = start + jnp.arange(Q_BLOCK, dtype=jnp.int32)
        bucket = rel_bucket(kpos[None, :] - qpos[:, None])
        bias = jnp.transpose(rel_bias[bucket], (2, 0, 1)).astype(jnp.float32)
        s = jnp.einsum('bqhmd,bkhmd->bhmqk', qblk, k).astype(jnp.float32) * scale
        s = s + bias[None, :, None]
        p = jax.nn.softmax(s, axis=-1)
        a = p[:, :, 0] - lam * p[:, :, 1]
        return jnp.einsum('bhqk,bkhe->bqhe', a.astype(v.dtype), v)

    o = lax.map(one_block, (qb, starts))
    return o.transpose(1, 0, 2, 3, 4).reshape(B, S, N_HEADS, V_DIM)


def mixer_ab(h, w_in, w_out, lq1, lk1, lq2, lk2, subln_g, rel_bias, lambda_init):
    B, S, _ = h.shape
    z = h @ w_in
    q = z[..., :ATTN_WIDTH].reshape(B, S, N_HEADS, 2, HEAD_DIM)
    k = z[..., ATTN_WIDTH:2 * ATTN_WIDTH].reshape(B, S, N_HEADS, 2, HEAD_DIM)
    v = z[..., 2 * ATTN_WIDTH:3 * ATTN_WIDTH].reshape(B, S, N_HEADS, V_DIM)
    f = z[..., 3 * ATTN_WIDTH:]
    lam = (jnp.exp(jnp.sum(lq1.astype(jnp.float32) * lk1.astype(jnp.float32)))
           - jnp.exp(jnp.sum(lq2.astype(jnp.float32) * lk2.astype(jnp.float32)))
           + lambda_init)
    o = diff_attention(q, k, v, rel_bias, lam)
    o = (rms_norm(o, subln_g) * (1.0 - lambda_init)).reshape(B, S, ATTN_WIDTH)
    fg = f.reshape(B, S, N_FGROUPS, FGROUP_DIM).astype(jnp.float32)
    fo = jnp.real(jnp.fft.fft2(fg, axes=(1, 3), norm='ortho'))
    fo = fo.astype(h.dtype).reshape(B, S, FOURIER_WIDTH)
    return jnp.concatenate([o, fo], axis=-1) @ w_out


def mixer_c(h, w_in, conv_w, w_out):
    z = h @ w_in
    bg, cg, xv = jnp.split(z, 3, axis=-1)
    return (bg * dwconv3(cg * xv, conv_w)) @ w_out


def conv_ffn(h, w_gate, w_up, conv_w, conv_b, w_down):
    g = dwconv3(h @ w_gate, conv_w) + conv_b
    return (jax.nn.silu(g) * (h @ w_up)) @ w_down


def run_trunk(x, rel_bias, norm_pre_mix, norm_post_mix, norm_pre_ffn, norm_post_ffn,
              ab_w_in, ab_w_out, ab_lambda_q1, ab_lambda_k1, ab_lambda_q2, ab_lambda_k2, ab_subln,
              c_w_in, c_conv, c_w_out, ffn_w_gate, ffn_w_up, ffn_conv, ffn_conv_b, ffn_w_down):
    for i in range(DEPTH):
        j = i // 2
        h = rms_norm(x, norm_pre_mix[i])
        if i % 2 == 0:
            m = mixer_ab(h, ab_w_in[j], ab_w_out[j], ab_lambda_q1[j], ab_lambda_k1[j],
                         ab_lambda_q2[j], ab_lambda_k2[j], ab_subln[j], rel_bias,
                         lambda_init_fn(i))
        else:
            m = mixer_c(h, c_w_in[j], c_conv[j], c_w_out[j])
        x = x + rms_norm(m, norm_post_mix[i])
        h = rms_norm(x, norm_pre_ffn[i])
        f = conv_ffn(h, ffn_w_gate[i], ffn_w_up[i], ffn_conv[i], ffn_conv_b[i], ffn_w_down[i])
        x = x + rms_norm(f, norm_post_ffn[i])
    return x


def setup_inputs(seed: int = 0) -> dict:
    key = jax.random.key(seed)
    ks = jax.random.split(key, 24)
    f32 = jnp.float32

    def nrm(k, shape, scale):
        return jax.random.normal(k, shape, f32) * scale

    def gain(k, shape):
        return 1.0 + 0.05 * jax.random.normal(k, shape, f32)

    return {
        "x_prompt": nrm(ks[0], (BATCH, SEQ, D_MODEL), 1.0),
        "x_sample": nrm(ks[1], (DEC_BATCH, DEC_SEQ, D_MODEL), 1.0),
        "rel_bias": nrm(ks[2], (NUM_BUCKETS, N_HEADS), 0.5),
        "norm_pre_mix": gain(ks[3], (DEPTH, D_MODEL)),
        "norm_post_mix": gain(ks[4], (DEPTH, D_MODEL)),
        "norm_pre_ffn": gain(ks[5], (DEPTH, D_MODEL)),
        "norm_post_ffn": gain(ks[6], (DEPTH, D_MODEL)),
        "ab_w_in": nrm(ks[7], (N_AB_LAYERS, D_MODEL, AB_IN_WIDTH), D_MODEL ** -0.5),
        "ab_w_out": nrm(ks[8], (N_AB_LAYERS, D_MODEL, D_MODEL), D_MODEL ** -0.5),
        "ab_lambda_q1": nrm(ks[9], (N_AB_LAYERS, HEAD_DIM), 0.1),
        "ab_lambda_k1": nrm(ks[10], (N_AB_LAYERS, HEAD_DIM), 0.1),
        "ab_lambda_q2": nrm(ks[11], (N_AB_LAYERS, HEAD_DIM), 0.1),
        "ab_lambda_k2": nrm(ks[12], (N_AB_LAYERS, HEAD_DIM), 0.1),
        "ab_subln": gain(ks[13], (N_AB_LAYERS, V_DIM)),
        "c_w_in": nrm(ks[14], (N_C_LAYERS, D_MODEL, 3 * CONV_DIM), D_MODEL ** -0.5),
        "c_conv": nrm(ks[15], (N_C_LAYERS, CONV_K, CONV_DIM), CONV_K ** -0.5),
        "c_w_out": nrm(ks[16], (N_C_LAYERS, CONV_DIM, D_MODEL), CONV_DIM ** -0.5),
        "ffn_w_gate": nrm(ks[17], (DEPTH, D_MODEL, D_FF), D_MODEL ** -0.5),
        "ffn_w_up": nrm(ks[18], (DEPTH, D_MODEL, D_FF), D_MODEL ** -0.5),
        "ffn_conv": nrm(ks[19], (DEPTH, CONV_K, D_FF), CONV_K ** -0.5),
        "ffn_conv_b": nrm(ks[20], (DEPTH, D_FF), 0.02),
        "ffn_w_down": nrm(ks[21], (DEPTH, D_FF, D_MODEL), D_FF ** -0.5),
    }


def reference(x_prompt, x_sample, rel_bias, norm_pre_mix, norm_post_mix, norm_pre_ffn, norm_post_ffn,
              ab_w_in, ab_w_out, ab_lambda_q1, ab_lambda_k1, ab_lambda_q2, ab_lambda_k2, ab_subln,
              c_w_in, c_conv, c_w_out, ffn_w_gate, ffn_w_up, ffn_conv, ffn_conv_b, ffn_w_down):
    y_prompt = run_trunk(x_prompt, rel_bias, norm_pre_mix, norm_post_mix, norm_pre_ffn, norm_post_ffn,
                         ab_w_in, ab_w_out, ab_lambda_q1, ab_lambda_k1, ab_lambda_q2, ab_lambda_k2,
                         ab_subln, c_w_in, c_conv, c_w_out, ffn_w_gate, ffn_w_up, ffn_conv,
                         ffn_conv_b, ffn_w_down)
    y_sample = run_trunk(x_sample, rel_bias, norm_pre_mix, norm_post_mix, norm_pre_ffn, norm_post_ffn,
                         ab_w_in, ab_w_out, ab_lambda_q1, ab_lambda_k1, ab_lambda_q2, ab_lambda_k2,
                         ab_subln, c_w_in, c_conv, c_w_out, ffn_w_gate, ffn_w_up, ffn_conv,
                         ffn_conv_b, ffn_w_down)
    return (y_prompt, y_sample)
```

```cpp
#include <hip/hip_runtime.h>
#include <hip/hip_cooperative_groups.h>
#include <cstdio>
#include <cstdint>
namespace cg = cooperative_groups;

#ifndef MK_ONE_LAUNCH
#define MK_ONE_LAUNCH 1
#endif

#define LAS __attribute__((address_space(3)))
typedef unsigned short bf16_t;
typedef short bf16x8 __attribute__((ext_vector_type(8)));
typedef float f32x4 __attribute__((ext_vector_type(4)));
typedef float f32x16 __attribute__((ext_vector_type(16)));
typedef unsigned u32x4 __attribute__((ext_vector_type(4)));
typedef unsigned u32x2 __attribute__((ext_vector_type(2)));
typedef float f32x2_t __attribute__((ext_vector_type(2)));
typedef __bf16 bf16x2_t __attribute__((ext_vector_type(2)));

constexpr int DM = 2048, NTOK = 24576, NTOK_P = 8192, SEQ_P = 4096, SEQ_S = 2048, DFF = 5632, NLAYER = 4;
constexpr float EPS = 1e-6f;
constexpr float LOG2E = 1.4426950408889634f;
constexpr float QSCALE = 0.125f * LOG2E;

constexpr size_t MiB = 1u << 20;
constexpr size_t WS_CTL = 0;
constexpr size_t WS_BAR = 65536;
constexpr size_t WS_CNT = 131072;
constexpr size_t ZERO_OFF = 65536, ZERO_BYTES = 1048576 - 65536;
constexpr size_t WS_X1 = 1 * MiB;
constexpr size_t WS_RSS = 262144, RSS_BYTES = 8 * 24576 * 4;
constexpr size_t WS_WB = 4 * MiB;
constexpr size_t WS_WB1 = 70 * MiB;
constexpr size_t WS_H = 136 * MiB;
constexpr size_t WS_DFTC = 232 * MiB;
constexpr size_t WS_CS4 = 233 * MiB;
constexpr size_t WS_CS2 = 297 * MiB;
constexpr size_t WS_SCR = 313 * MiB;
constexpr size_t WS_END = WS_SCR + 528 * MiB;
constexpr size_t WB_QKF = 0, WB_V = 12 * MiB, WB_OUT = 16 * MiB;
constexpr size_t WB_CX = 0, WB_CB = 16 * MiB, WB_COUT = 24 * MiB;
constexpr size_t WB_G = 0, WB_U = 22 * MiB, WB_D = 44 * MiB;
constexpr size_t SC_GATE = 0, SC_ACT = 264 * MiB, SC_FM = 0;
constexpr size_t SC_ZQKF = 0, SC_VT = 144 * MiB, SC_CAT = 192 * MiB, SC_YT = 288 * MiB, SC_ABM = 384 * MiB;
constexpr size_t SC_P = 0, SC_U = 96 * MiB, SC_CM = 192 * MiB;
constexpr size_t YT_S_OFF = (size_t)4 * 256 * 2 * 2 * SEQ_P * 2;

constexpr int LDS_BYTES = 147456;
constexpr int LDS_BT = 131072;
constexpr int LDS_MISC = 133120;
constexpr int LDS_EPI = 134144;

__device__ __forceinline__ unsigned cvtpk(float lo, float hi) { f32x2_t v = {lo, hi}; bf16x2_t b = __builtin_convertvector(v, bf16x2_t); return __builtin_bit_cast(unsigned, b); }
__device__ __forceinline__ float bflo(unsigned u) { return __uint_as_float(u << 16); }
__device__ __forceinline__ float bfhi(unsigned u) { return __uint_as_float(u & 0xffff0000u); }
__device__ __forceinline__ float wave_sum(float v) {
#pragma unroll
    for (int o = 1; o < 64; o <<= 1) v += __shfl_xor(v, o);
    return v;
}

typedef unsigned rss_t;
constexpr float RSS_FX = 16384.f, RSS_INV = 1.f / (16384.f * 2048.f);
__device__ __forceinline__ float rss_rstd(rss_t v) { return __builtin_amdgcn_rsqf((float)v * RSS_INV + 1e-6f); }
namespace pg8 {
constexpr int BM = 256, BK = 64, HALF = 128, HTB = HALF * BK * 2, NXCD = 8, WGM = 8;
__device__ __forceinline__ int lds_byte(int r, int c) { const int st = (r >> 4) * 2 + (c >> 5), rr = r & 15, cc = c & 31, ob = rr * 64 + cc * 2; return st * 1024 + (ob ^ (((ob >> 9) & 1) << 5)); }
__device__ __forceinline__ void stage_rc(int b, int& R, int& C) { const int st = b / 1024, sb = b % 1024, swz = sb ^ (((sb >> 9) & 1) << 5); R = (st >> 1) * 16 + swz / 64; C = (st & 1) * 32 + (swz % 64) / 2; }
__device__ __forceinline__ int perm32(int rho) { const int n = rho >> 4, i = rho & 15; return 8 * (i >> 2) + 4 * n + (i & 3); }

struct Unit { int pm, pn, z; };

__device__ __forceinline__ void tile_map(int L, int nM, int nN, int& pm, int& pn) {
    const int nwg = nM * nN; int wgid = L;
    { const int q = nwg / NXCD, r = nwg % NXCD, xcd = wgid % NXCD, off = wgid / NXCD; wgid = (xcd < r ? xcd * (q + 1) : r * (q + 1) + (xcd - r) * q) + off; }
    const int nig = WGM * nN, gid = wgid / nig, fm = gid * WGM, gsz = (nM - fm) < WGM ? (nM - fm) : WGM;
    pm = fm + ((wgid % nig) % gsz); pn = (wgid % nig) / gsz;
}

template <class Prob, class Epi>
__device__ __forceinline__ void gemm_phase(LAS unsigned char* lds, const Prob& P, const Epi& E) {
    int tid = threadIdx.x; asm volatile("" : "+v"(tid));
    const int wid = __builtin_amdgcn_readfirstlane(tid >> 6), lane = tid & 63, wr = wid >> 2, wc = wid & 3, fr = lane & 15, fq = lane >> 4;
    const int K = P.K, nt = K / BK, lda = P.lda, ldb = P.ldb;
    unsigned voffA[2], voffB[2];
#pragma unroll
    for (int i = 0; i < 2; ++i) { int R, C; stage_rc(tid * 16 + i * 8192, R, C); const int Rb = (R & ~31) + perm32(R & 31);
        voffA[i] = (unsigned)(R * lda + C) * 2u; voffB[i] = (unsigned)(Rb * ldb + C) * 2u; }
    const size_t kstep = (size_t)(BK * 2);
    const size_t hstepA = (size_t)HALF * lda * 2, hstepB = (size_t)HALF * ldb * 2;
    const unsigned ldsw = (unsigned)wid * 1024u;
    const int aoff = lds_byte(wr * 64 + fr, fq * 8), boff = lds_byte(wc * 32 + fr, fq * 8);
#define PG8_SA(b, h) (((b) * 2 + (h)) * HTB)
#define PG8_SB(b, h) ((4 + (b) * 2 + (h)) * HTB)
#define PG8_STAGE(bufoff, gbase, voff) do { _Pragma("unroll") for (int _i = 0; _i < 2; ++_i) \
        __builtin_amdgcn_global_load_lds((const unsigned*)((const char*)(gbase) + (voff)[_i]), (LAS unsigned*)(lds + (bufoff) + ldsw + _i * 8192), 16, 0, 0); } while (0)
#define PG8_LDA(dst, b, h) do { _Pragma("unroll") for (int m = 0; m < 4; ++m) _Pragma("unroll") for (int k = 0; k < 2; ++k) dst[m][k] = *(const LAS bf16x8*)(lds + PG8_SA(b, h) + aoff + m * 2048 + k * 1024); } while (0)
#define PG8_LDB(dst, b, h) do { _Pragma("unroll") for (int n = 0; n < 2; ++n) _Pragma("unroll") for (int k = 0; k < 2; ++k) dst[n][k] = *(const LAS bf16x8*)(lds + PG8_SB(b, h) + boff + n * 2048 + k * 1024); } while (0)
#define PG8_MMA(ai, bj, At, Bt) do { __builtin_amdgcn_s_setprio(1); _Pragma("unroll") for (int m = 0; m < 4; ++m) _Pragma("unroll") for (int n = 0; n < 2; ++n) _Pragma("unroll") for (int k = 0; k < 2; ++k) \
        acc[ai][bj][m][n] = __builtin_amdgcn_mfma_f32_16x16x32_bf16(Bt[n][k], At[m][k], acc[ai][bj][m][n], 0, 0, 0); __builtin_amdgcn_s_setprio(0); } while (0)
#define PG8_WAIT_V(n) asm volatile("s_waitcnt vmcnt(" #n ")" ::: "memory")
#define PG8_WAIT_L(n) asm volatile("s_waitcnt lgkmcnt(" #n ")" ::: "memory")
#define PG8_BAR __builtin_amdgcn_s_barrier()
#define PG8_SCHED __builtin_amdgcn_sched_barrier(0)
    Unit cur, nxt; int ui = 0;
    if (!P.next(0, cur)) return;
    f32x4 acc[2][2][4][2];
#pragma unroll
    for (int a = 0; a < 2; ++a)
#pragma unroll
        for (int b = 0; b < 2; ++b)
#pragma unroll
            for (int m = 0; m < 4; ++m)
#pragma unroll
                for (int n = 0; n < 2; ++n) acc[a][b][m][n] = (f32x4){0.f, 0.f, 0.f, 0.f};
    bf16x8 At[4][2], B0[2][2], B1[2][2];
    const char* cA = P.a_ptr(cur); const char* cB = P.b_ptr(cur);
    PG8_STAGE(PG8_SB(0, 0), cB, voffB); PG8_STAGE(PG8_SB(0, 1), cB + hstepB, voffB); PG8_STAGE(PG8_SA(0, 0), cA, voffA); PG8_STAGE(PG8_SA(0, 1), cA + hstepA, voffA);
    if (wr == 1) PG8_BAR;
    PG8_WAIT_V(2); PG8_BAR;
    PG8_STAGE(PG8_SB(1, 0), cB + kstep, voffB); PG8_STAGE(PG8_SA(1, 0), cA + kstep, voffA); PG8_STAGE(PG8_SB(1, 1), cB + hstepB + kstep, voffB);
    PG8_WAIT_V(6); PG8_BAR;
    for (;;) {
        const bool has_next = P.next(ui + 1, nxt);
        const char* nA = has_next ? P.a_ptr(nxt) : cA; const char* nB = has_next ? P.b_ptr(nxt) : cB;
        for (int t = 0; t < nt; t += 2) {
            const bool last = (t == nt - 2);
            const char* a1 = cA + (size_t)(t + 1) * kstep;
            const char* a2 = last ? nA : cA + (size_t)(t + 2) * kstep; const char* b2 = last ? nB : cB + (size_t)(t + 2) * kstep;
            const char* a3 = a2 + kstep; const char* b3 = b2 + kstep;
            PG8_LDB(B0, 0, 0); PG8_LDB(B1, 0, 1); PG8_SCHED; PG8_LDA(At, 0, 0); PG8_STAGE(PG8_SA(1, 1), a1 + hstepA, voffA);
            PG8_WAIT_V(8); PG8_WAIT_L(0); PG8_BAR; PG8_MMA(0, 0, At, B0); PG8_MMA(0, 1, At, B1); PG8_BAR; PG8_SCHED;
            PG8_LDA(At, 0, 1); PG8_STAGE(PG8_SB(0, 0), b2, voffB); PG8_STAGE(PG8_SB(0, 1), b2 + hstepB, voffB); PG8_STAGE(PG8_SA(0, 0), a2, voffA);
            PG8_WAIT_V(8); PG8_WAIT_L(0); PG8_BAR; PG8_MMA(1, 0, At, B0); PG8_MMA(1, 1, At, B1); PG8_BAR; PG8_SCHED;
            PG8_LDB(B0, 1, 0); PG8_LDB(B1, 1, 1); PG8_SCHED; PG8_LDA(At, 1, 0); PG8_STAGE(PG8_SA(0, 1), a2 + hstepA, voffA);
            PG8_WAIT_V(8); PG8_WAIT_L(0); PG8_BAR; PG8_MMA(0, 0, At, B0); PG8_MMA(0, 1, At, B1); PG8_BAR; PG8_SCHED;
            PG8_LDA(At, 1, 1); PG8_STAGE(PG8_SB(1, 0), b3, voffB); PG8_STAGE(PG8_SB(1, 1), b3 + hstepB, voffB); PG8_STAGE(PG8_SA(1, 0), a3, voffA);
            PG8_WAIT_V(8); PG8_WAIT_L(0); PG8_BAR; PG8_MMA(1, 0, At, B0); PG8_MMA(1, 1, At, B1); PG8_BAR; PG8_SCHED;
        }
        if (wr == 0) PG8_BAR;
        E(acc, cur, wr, wc, fr, fq);
        if (!has_next) break;
#pragma unroll
        for (int a = 0; a < 2; ++a)
#pragma unroll
            for (int b = 0; b < 2; ++b)
#pragma unroll
                for (int m = 0; m < 4; ++m)
#pragma unroll
                    for (int n = 0; n < 2; ++n) acc[a][b][m][n] = (f32x4){0.f, 0.f, 0.f, 0.f};
        cur = nxt; cA = nA; cB = nB; ++ui;
        if (wr == 1) PG8_BAR;
    }
    PG8_WAIT_V(0);
    PG8_BAR;
#undef PG8_SA
#undef PG8_SB
#undef PG8_STAGE
#undef PG8_LDA
#undef PG8_LDB
#undef PG8_MMA
#undef PG8_WAIT_V
#undef PG8_WAIT_L
#undef PG8_BAR
#undef PG8_SCHED
}

struct ProbSimple {
    const char* A; const char* B; int K, lda, ldb, nM, nN, G, c;
    __device__ __forceinline__ bool next(int i, Unit& u) const { const int L = i * G + c; if (L >= nM * nN) return false; tile_map(L, nM, nN, u.pm, u.pn); u.z = 0; return true; }
    __device__ __forceinline__ const char* a_ptr(const Unit& u) const { return A + (size_t)u.pm * 256 * lda * 2; }
    __device__ __forceinline__ const char* b_ptr(const Unit& u) const { return B + (size_t)u.pn * 256 * ldb * 2; }
};
struct ProbAB1 {
    const char* H; const char* Wqkf; const char* Wv; int K, lda, ldb, G, c;
    __device__ __forceinline__ bool next(int i, Unit& u) const {
        const int L = i * G + c; if (L >= 1536) return false;
        if (L < 1152) { tile_map(L, 96, 12, u.pm, u.pn); u.z = 0; } else { tile_map(L - 1152, 4, 96, u.pm, u.pn); u.z = 1; }
        return true; }
    __device__ __forceinline__ const char* a_ptr(const Unit& u) const { return (u.z ? Wv : H) + (size_t)u.pm * 256 * 2048 * 2; }
    __device__ __forceinline__ const char* b_ptr(const Unit& u) const { return (u.z ? H : Wqkf) + (size_t)u.pn * 256 * 2048 * 2; }
};
struct ProbF1 {
    const char* Cm; const char* F; int K, lda, ldb, G, c;
    __device__ __forceinline__ bool next(int i, Unit& u) const { const int L = i * G + c; if (L >= 768) return false; u.z = L / 192; tile_map(L % 192, 2, 96, u.pm, u.pn); return true; }
    __device__ __forceinline__ const char* a_ptr(const Unit& u) const { return Cm + (size_t)u.pm * 256 * 256 * 2; }
    __device__ __forceinline__ const char* b_ptr(const Unit& u) const { return F + (size_t)u.z * 256 * 2 + (size_t)u.pn * 256 * 3072 * 2; }
};
struct ProbF2 {
    const char* CS; const char* Y; int K, lda, ldb, nB, nPm, first, count;
    __device__ __forceinline__ bool next(int i, Unit& u) const { if (i >= count) return false; const int L = first + i; u.z = L / nPm; u.pm = L % nPm; u.pn = 0; return true; }
    __device__ __forceinline__ const char* a_ptr(const Unit& u) const { return CS + (size_t)u.pm * 256 * lda * 2; }
    __device__ __forceinline__ const char* b_ptr(const Unit& u) const { const int b = u.z >> 2, g = u.z & 3; return Y + ((size_t)(g * 256) * nB + b) * (size_t)K * 2; }
};

template <class Addr> struct EpiStore {
    Addr ad;
    __device__ __forceinline__ void operator()(const f32x4 (&acc)[2][2][4][2], const Unit& u, int wr, int wc, int fr, int fq) const {
        bf16_t* base; int ldc; float sc; const rss_t* rs; int rsm; ad.get(u, base, ldc, sc, rs, rsm);
        bf16_t* p0 = base + (size_t)(wr * 64 + fr) * ldc + wc * 32 + 8 * fq;
        f32x4 cs[2][2];
#pragma unroll
        for (int bj = 0; bj < 2; ++bj)
#pragma unroll
            for (int n = 0; n < 2; ++n) { cs[bj][n] = (f32x4){sc, sc, sc, sc};
                if (rsm == 2) { const rss_t* q = rs + bj * HALF + wc * 32 + 8 * fq + 4 * n;
#pragma unroll
                    for (int e = 0; e < 4; ++e) cs[bj][n][e] = sc * rss_rstd(q[e]); } }
#pragma unroll
        for (int ai = 0; ai < 2; ++ai)
#pragma unroll
            for (int m = 0; m < 4; ++m) { bf16_t* rowp = p0 + (size_t)(ai * HALF + m * 16) * ldc;
                float rsc = 1.f; if (rsm == 1) rsc = rss_rstd(rs[ai * HALF + wr * 64 + m * 16 + fr]);
#pragma unroll
                for (int bj = 0; bj < 2; ++bj) { const f32x4 v0 = acc[ai][bj][m][0] * cs[bj][0] * rsc, v1 = acc[ai][bj][m][1] * cs[bj][1] * rsc;
                    u32x4 w; w.x = cvtpk(v0[0], v0[1]); w.y = cvtpk(v0[2], v0[3]); w.z = cvtpk(v1[0], v1[1]); w.w = cvtpk(v1[2], v1[3]);
                    *(u32x4*)(rowp + bj * HALF) = w; } }
    }
};
struct AddrPlain { bf16_t* out; int ldc; const rss_t* rss;
    __device__ __forceinline__ void get(const Unit& u, bf16_t*& base, int& l, float& sc, const rss_t*& rs, int& rsm) const { base = out + (size_t)u.pm * 256 * ldc + u.pn * 256; l = ldc; sc = 1.f;
        rs = rss + u.pm * 256; rsm = rss ? 1 : 0; } };
struct AddrAB1 { bf16_t* zqkf; bf16_t* vt; const rss_t* rss;
    __device__ __forceinline__ void get(const Unit& u, bf16_t*& base, int& l, float& sc, const rss_t*& rs, int& rsm) const {
        if (u.z == 0) { base = zqkf + (size_t)u.pm * 256 * 3072 + u.pn * 256; l = 3072; sc = (u.pn < 4) ? QSCALE : 1.f; rs = rss + u.pm * 256; rsm = 1; }
        else { base = vt + (size_t)u.pm * 256 * NTOK + u.pn * 256; l = NTOK; sc = 1.f; rs = rss + u.pn * 256; rsm = 2; } } };
struct AddrF1 { bf16_t* yt;
    __device__ __forceinline__ void get(const Unit& u, bf16_t*& base, int& l, float& sc, const rss_t*& rs, int& rsm) const {
        sc = 1.f; rs = nullptr; rsm = 0; const int g = u.z;
        if (u.pn < 32) { const int b = u.pn >> 4, s0 = (u.pn & 15) * 256; base = yt + ((size_t)(g * 256) * 2 + b) * 8192 + (size_t)u.pm * 4096 + s0; l = 2 * 8192; }
        else { const int t = u.pn * 256 - NTOK_P, b = t >> 11, s0 = t & 2047; base = yt + YT_S_OFF / 2 + ((size_t)(g * 256) * 8 + b) * 4096 + (size_t)u.pm * 2048 + s0; l = 8 * 4096; } } };
struct AddrF2 { bf16_t* cat; int tok0, S;
    __device__ __forceinline__ void get(const Unit& u, bf16_t*& base, int& l, float& sc, const rss_t*& rs, int& rsm) const {
        rs = nullptr; rsm = 0; const int b = u.z >> 2, g = u.z & 3; base = cat + (size_t)(tok0 + b * S + u.pm * 256) * DM + 1024 + g * 256; l = DM; sc = 1.f; } };

struct ProbF1G {
    const char* Hh; const char* Wg; const char* Wu; int K, lda, ldb, G, c;
    __device__ __forceinline__ bool next(int i, Unit& u) const {
        const int L = i * G + c; if (L >= 2304) return false;
        if (L < 2112) { tile_map(L, 96, 22, u.pm, u.pn); u.z = 0; } else { tile_map(L - 2112, 96, 2, u.pm, u.pn); u.z = 1; }
        return true; }
    __device__ __forceinline__ const char* a_ptr(const Unit& u) const { return Hh + (size_t)u.pm * 256 * 2048 * 2; }
    __device__ __forceinline__ const char* b_ptr(const Unit& u) const { return (u.z ? Wu + (size_t)20 * 256 * 2048 * 2 : Wg) + (size_t)u.pn * 256 * 2048 * 2; }
};
struct AddrF1G { bf16_t* gate; bf16_t* upraw; const rss_t* rss;
    __device__ __forceinline__ void get(const Unit& u, bf16_t*& base, int& l, float& sc, const rss_t*& rs, int& rsm) const { sc = 1.f; rs = rss + u.pm * 256;
        if (u.z == 0) { base = gate + (size_t)u.pm * 256 * DFF + u.pn * 256; l = DFF; rsm = 1; } else { base = upraw + (size_t)u.pm * 256 * 512 + u.pn * 256; l = 512; rsm = 0; } } };
struct EpiMulHalves {
    bf16_t* out; int ldc; const rss_t* rss;
    __device__ __forceinline__ void operator()(const f32x4 (&acc)[2][2][4][2], const Unit& u, int wr, int wc, int fr, int fq) const {
        bf16_t* p0 = out + (size_t)(u.pm * 256 + wr * 64 + fr) * ldc + u.pn * 128 + wc * 32 + 8 * fq;
#pragma unroll
        for (int ai = 0; ai < 2; ++ai)
#pragma unroll
            for (int m = 0; m < 4; ++m) { const float r2 = 1.f / ((float)rss[u.pm * 256 + ai * HALF + wr * 64 + m * 16 + fr] * RSS_INV + 1e-6f);
                const f32x4 v0 = acc[ai][0][m][0] * acc[ai][1][m][0] * r2, v1 = acc[ai][0][m][1] * acc[ai][1][m][1] * r2;
                u32x4 w; w.x = cvtpk(v0[0], v0[1]); w.y = cvtpk(v0[2], v0[3]); w.z = cvtpk(v1[0], v1[1]); w.w = cvtpk(v1[2], v1[3]);
                *(u32x4*)(p0 + (size_t)(ai * HALF + m * 16) * ldc) = w; }
    }
};
template <bool SILU> struct EpiConvMul {
    const bf16_t* src; bf16_t* out; const float* cw; const float* cb; int ld;
    unsigned* wcnt; unsigned wtarget; unsigned* tmo; LAS unsigned char* l2;
    __device__ __forceinline__ void operator()(const f32x4 (&acc)[2][2][4][2], const Unit& u, int wr, int wc, int fr, int fq) const {
        if (wcnt) { volatile LAS unsigned* fl = (volatile LAS unsigned*)(l2 + 5120);
            if (*fl == 0u) {
                if (threadIdx.x == 0) { unsigned sp = 0;
                    while (__hip_atomic_load(wcnt, __ATOMIC_RELAXED, __HIP_MEMORY_SCOPE_AGENT) < wtarget) { __builtin_amdgcn_s_sleep(1);
                        if ((++sp & 255u) == 0u) { if (__hip_atomic_load(tmo, __ATOMIC_RELAXED, __HIP_MEMORY_SCOPE_AGENT)) break; if (sp > (1u << 22)) { atomicAdd(tmo, 1u); break; } } }
                    __builtin_amdgcn_fence(__ATOMIC_ACQUIRE, "agent"); }
                asm volatile("s_waitcnt vmcnt(0) lgkmcnt(0)" ::: "memory"); __builtin_amdgcn_s_barrier();
                if (threadIdx.x == 0) *fl = 1u;
                asm volatile("s_waitcnt lgkmcnt(0)" ::: "memory"); __builtin_amdgcn_s_barrier(); asm volatile("" ::: "memory"); } }
        const int lane = threadIdx.x & 63; const int laneR = (lane & 48) | ((lane - 1) & 15), laneL = (lane & 48) | ((lane + 1) & 15);
#pragma unroll
        for (int bj = 0; bj < 2; ++bj) {
            const int c0 = u.pn * 256 + bj * HALF + wc * 32 + 8 * fq;
            float w0[8], w1[8], w2[8], bb[8];
#pragma unroll
            for (int h = 0; h < 2; ++h) { const f32x4 a = *(const f32x4*)(cw + c0 + 4 * h), b = *(const f32x4*)(cw + ld + c0 + 4 * h), c = *(const f32x4*)(cw + 2 * ld + c0 + 4 * h);
                f32x4 d = (f32x4){0.f, 0.f, 0.f, 0.f}; if (SILU) d = *(const f32x4*)(cb + c0 + 4 * h);
#pragma unroll
                for (int e = 0; e < 4; ++e) { w0[4 * h + e] = a[e]; w1[4 * h + e] = b[e]; w2[4 * h + e] = c[e]; bb[4 * h + e] = d[e]; } }
#pragma unroll
            for (int ai = 0; ai < 2; ++ai) {
                u32x4 cur[4], et, eb;
                {
                    const int row0 = u.pm * 256 + ai * HALF + wr * 64;
                    const int smask = row0 < NTOK_P ? (SEQ_P - 1) : (SEQ_S - 1);
                    const bool hp = (row0 & smask) != 0, hn = ((row0 + 63) & smask) != smask;
                    const bf16_t* sp = src + (size_t)(row0 + fr) * ld + c0;
#pragma unroll
                    for (int m = 0; m < 4; ++m) cur[m] = *(const u32x4*)(sp + (size_t)(m * 16) * ld);
                    const bf16_t* s0 = src + (size_t)row0 * ld + c0;
                    et = *(const u32x4*)(hp ? s0 - ld : s0); eb = *(const u32x4*)(hn ? s0 + (size_t)64 * ld : s0);
                    if (!hp) et = (u32x4){0u, 0u, 0u, 0u}; if (!hn) eb = (u32x4){0u, 0u, 0u, 0u};
                }
                asm volatile("" ::: "memory");
                u32x4 Rp = et;
#pragma unroll
                for (int m = 0; m < 4; ++m) {
                    const int row = u.pm * 256 + ai * HALF + wr * 64 + m * 16 + fr;
                    const u32x4 cu = cur[m];
                    u32x4 R, L, Ln;
#pragma unroll
                    for (int e = 0; e < 4; ++e) { R[e] = (unsigned)__shfl((int)cu[e], laneR); L[e] = (unsigned)__shfl((int)cu[e], laneL); }
                    if (m < 3) {
#pragma unroll
                        for (int e = 0; e < 4; ++e) Ln[e] = (unsigned)__shfl((int)cur[m < 3 ? m + 1 : 3][e], laneL);
                    } else Ln = eb;
                    u32x4 pv, nx;
#pragma unroll
                    for (int e = 0; e < 4; ++e) { pv[e] = fr == 0 ? Rp[e] : R[e]; nx[e] = fr == 15 ? Ln[e] : L[e]; }
                    Rp = R;
                    float r[8];
#pragma unroll
                    for (int e = 0; e < 4; ++e) {
                        float g0 = w0[2 * e] * bflo(pv[e]) + w1[2 * e] * bflo(cu[e]) + w2[2 * e] * bflo(nx[e]) + bb[2 * e];
                        float g1 = w0[2 * e + 1] * bfhi(pv[e]) + w1[2 * e + 1] * bfhi(cu[e]) + w2[2 * e + 1] * bfhi(nx[e]) + bb[2 * e + 1];
                        if (SILU) { g0 = g0 * __builtin_amdgcn_rcpf(1.f + __builtin_amdgcn_exp2f(-g0 * LOG2E)); g1 = g1 * __builtin_amdgcn_rcpf(1.f + __builtin_amdgcn_exp2f(-g1 * LOG2E)); }
                        r[2 * e] = g0 * acc[ai][bj][m][e >> 1][(2 * e) & 3]; r[2 * e + 1] = g1 * acc[ai][bj][m][e >> 1][(2 * e + 1) & 3]; }
                    u32x4 w; w.x = cvtpk(r[0], r[1]); w.y = cvtpk(r[2], r[3]); w.z = cvtpk(r[4], r[5]); w.w = cvtpk(r[6], r[7]);
                    *(u32x4*)(out + (size_t)row * ld + c0) = w; }
                asm volatile("" ::: "memory");
            }
            asm volatile("" ::: "memory");
        }
    }
};
struct ProbPanel {
    const char* A; const char* B; int K, lda, ldb, bx;
    __device__ __forceinline__ bool next(int i, Unit& u) const { if (i >= 3) return false; const int slot = bx >> 3; u.pm = i * 32 + (bx & 7) * 4 + (slot >> 3); u.pn = slot & 7; u.z = 0; return true; }
    __device__ __forceinline__ const char* a_ptr(const Unit& u) const { return A + (size_t)u.pm * 256 * lda * 2; }
    __device__ __forceinline__ const char* b_ptr(const Unit& u) const { return B + (size_t)u.pn * 256 * ldb * 2; }
};
__device__ __forceinline__ void panel_rstd(const f32x4 (&v)[2][2][4][2], int pm, int pn, int wr, int wc, int fr, int fq, float* X, unsigned* cnt, unsigned* tmo, LAS unsigned char* l2, int tid, const rss_t* rin) {
    LAS float* Pp = (LAS float*)l2; LAS float* S = (LAS float*)(l2 + 4096);
    const int wid = __builtin_amdgcn_readfirstlane(tid >> 6), lane = tid & 63;
#pragma unroll
    for (int ai = 0; ai < 2; ++ai)
#pragma unroll
        for (int m = 0; m < 4; ++m) { float s = 0.f;
#pragma unroll
            for (int bj = 0; bj < 2; ++bj)
#pragma unroll
                for (int n = 0; n < 2; ++n) { const f32x4 x = v[ai][bj][m][n]; s += (x[0] * x[0] + x[1] * x[1]) + (x[2] * x[2] + x[3] * x[3]); }
            s += __shfl_xor(s, 16); s += __shfl_xor(s, 32);
            if (fq == 0) Pp[(ai * HALF + wr * 64 + m * 16 + fr) * 4 + wc] = s; }
    asm volatile("s_waitcnt lgkmcnt(0)" ::: "memory"); __builtin_amdgcn_s_barrier(); asm volatile("" ::: "memory");
    if (tid < 256) { const float t = (Pp[tid * 4] + Pp[tid * 4 + 1]) + (Pp[tid * 4 + 2] + Pp[tid * 4 + 3]);
        __hip_atomic_store((unsigned*)X + ((size_t)(pm * 256 + tid) * 8 + pn), __float_as_uint(t), __ATOMIC_RELAXED, __HIP_MEMORY_SCOPE_AGENT); }
    asm volatile("s_waitcnt vmcnt(0)" ::: "memory");
    if (tid < 256 && lane == 0) __hip_atomic_fetch_add(cnt, 1u, __ATOMIC_RELAXED, __HIP_MEMORY_SCOPE_AGENT);
    if (wid == 0) {
        unsigned sp = 0;
        for (;;) {
            if ((unsigned)__builtin_amdgcn_readfirstlane(__hip_atomic_load(cnt, __ATOMIC_RELAXED, __HIP_MEMORY_SCOPE_AGENT)) >= 32u) break;
            __builtin_amdgcn_s_sleep(1);
            if ((++sp & 255u) == 0u) { if (__hip_atomic_load(tmo, __ATOMIC_RELAXED, __HIP_MEMORY_SCOPE_AGENT)) break; if (sp > (1u << 22)) { if (lane == 0) atomicAdd(tmo, 1u); break; } }
        }
        __builtin_amdgcn_fence(__ATOMIC_ACQUIRE, "agent");
    }
    asm volatile("s_waitcnt vmcnt(0) lgkmcnt(0)" ::: "memory"); __builtin_amdgcn_s_barrier(); asm volatile("" ::: "memory");
    if (tid < 256) { const unsigned long long* sl = (const unsigned long long*)((const unsigned*)X + (size_t)(pm * 256 + tid) * 8); float ss = 0.f;
#pragma unroll
        for (int t = 0; t < 4; ++t) { const unsigned long long w = __hip_atomic_load(sl + t, __ATOMIC_RELAXED, __HIP_MEMORY_SCOPE_AGENT); ss += __uint_as_float((unsigned)w) + __uint_as_float((unsigned)(w >> 32)); }
        float rs = 1.f; if (rin) rs = rss_rstd(rin[pm * 256 + tid]);
        S[tid] = rs * __builtin_amdgcn_rsqf(rs * rs * ss * (1.f / 2048.f) + 1e-6f); }
    asm volatile("s_waitcnt lgkmcnt(0)" ::: "memory"); __builtin_amdgcn_s_barrier(); asm volatile("" ::: "memory");
}
struct EpiNormRes {
    bf16_t* xb; float* fout; const float* gpost; rss_t* rss_out; const rss_t* rss_in; float* X1; unsigned* cnt1; unsigned* tmo; LAS unsigned char* l2;
    __device__ __forceinline__ void operator()(f32x4 (&acc)[2][2][4][2], const Unit& u, int wr, int wc, int fr, int fq) const {
        int tid = threadIdx.x; asm volatile("" : "+v"(tid));
        const LAS float* S = (const LAS float*)(l2 + 4096);
        const int col0 = u.pn * 256 + wc * 32 + 8 * fq;
        const size_t toff = (size_t)(u.pm * 256 + wr * 64 + fr) * DM + col0;
        bf16_t* xt = xb + toff;
        u32x4 pre[4][2];
#define NR_LOAD(ai) do { _Pragma("unroll") for (int m = 0; m < 4; ++m) _Pragma("unroll") for (int bj = 0; bj < 2; ++bj) \
            pre[m][bj] = *(const u32x4*)(xt + (size_t)((ai) * HALF + m * 16) * DM + bj * HALF); asm volatile("" ::: "memory"); } while (0)
#define NR_APPLY(ai) do { _Pragma("unroll") for (int m = 0; m < 4; ++m) { const int rl_ = (ai) * HALF + wr * 64 + m * 16 + fr; const float r1 = S[rl_]; float q_ = 0.f; \
            _Pragma("unroll") for (int bj = 0; bj < 2; ++bj) { const u32x4 pv_ = pre[m][bj]; f32x4 xn0_, xn1_; \
                xn0_[0] = bflo(pv_[0]); xn0_[1] = bfhi(pv_[0]); xn0_[2] = bflo(pv_[1]); xn0_[3] = bfhi(pv_[1]); xn1_[0] = bflo(pv_[2]); xn1_[1] = bfhi(pv_[2]); xn1_[2] = bflo(pv_[3]); xn1_[3] = bfhi(pv_[3]); \
                xn0_ = xn0_ + acc[ai][bj][m][0] * r1 * g[bj][0]; xn1_ = xn1_ + acc[ai][bj][m][1] * r1 * g[bj][1]; \
                if (fout) { float* fo_ = fout + toff + (size_t)((ai) * HALF + m * 16) * DM + bj * HALF; *(f32x4*)fo_ = xn0_; *(f32x4*)(fo_ + 4) = xn1_; } \
                else { u32x4 w_; w_.x = cvtpk(xn0_[0], xn0_[1]); w_.y = cvtpk(xn0_[2], xn0_[3]); w_.z = cvtpk(xn1_[0], xn1_[1]); w_.w = cvtpk(xn1_[2], xn1_[3]); \
                    *(u32x4*)(xt + (size_t)((ai) * HALF + m * 16) * DM + bj * HALF) = w_; \
                      \
                    const float a0_ = bflo(w_.x), a1_ = bfhi(w_.x), a2_ = bflo(w_.y), a3_ = bfhi(w_.y), a4_ = bflo(w_.z), a5_ = bfhi(w_.z), a6_ = bflo(w_.w), a7_ = bfhi(w_.w); \
                    q_ += ((a0_ * a0_ + a1_ * a1_) + (a2_ * a2_ + a3_ * a3_)) + ((a4_ * a4_ + a5_ * a5_) + (a6_ * a6_ + a7_ * a7_)); } } \
            if (!fout) { q_ += __shfl_xor(q_, 16); q_ += __shfl_xor(q_, 32); if (fq == 0) atomicAdd(rss_out + u.pm * 256 + rl_, (rss_t)(q_ * RSS_FX + 0.5f)); } } asm volatile("" ::: "memory"); } while (0)
        NR_LOAD(0);
        panel_rstd(acc, u.pm, u.pn, wr, wc, fr, fq, X1, cnt1 + u.pm * 16, tmo, l2, tid, rss_in);
        {
            f32x4 g[2][2];
#pragma unroll
            for (int bj = 0; bj < 2; ++bj) { g[bj][0] = *(const f32x4*)(gpost + col0 + bj * HALF); g[bj][1] = *(const f32x4*)(gpost + col0 + bj * HALF + 4); }
            NR_APPLY(0);
            NR_LOAD(1); NR_APPLY(1);
        }
#undef NR_LOAD
#undef NR_APPLY
    }
};
}

constexpr int AT_STAGE = 36864, AT_K1 = 9216, AT_V = 18432, AT_PITCH = 144;
__device__ __forceinline__ void attn_unit(LAS unsigned char* lds, const bf16_t* __restrict__ zqkf, const bf16_t* __restrict__ Vt, bf16_t* cat,
                                          const float* __restrict__ biasT, const float* __restrict__ subln, float lam, float oscale, int tokbase, int S, int h, int q0) {
    int tid = threadIdx.x; asm volatile("" : "+v"(tid));
    const int lane = tid & 63, w = __builtin_amdgcn_readfirstlane(tid >> 6), g = w & 3, mp = w >> 2, r32 = lane & 31, hi = lane >> 5;
    LAS float* bt = (LAS float*)(lds + LDS_BT);
    if (tid < 257) bt[tid] = biasT[h * 260 + tid];
    const float cL = biasT[h * 260], cR = biasT[h * 260 + 256];
    bf16x8 qr[4];
    { const bf16_t* qp = zqkf + (size_t)(tokbase + q0 + 32 * g + r32) * 3072 + h * 128 + mp * 64 + 8 * hi;
#pragma unroll
      for (int d0 = 0; d0 < 4; ++d0) qr[d0] = *(const bf16x8*)(qp + 16 * d0); }
    const int NT = S >> 6;
    unsigned voff[5];
#pragma unroll
    for (int k = 0; k < 5; ++k) { const int q = w + 8 * k; const int sp = q < 9 ? q : (q < 18 ? q - 9 : q - 18); const int ci = sp * 64 + lane; const int row = ci / 9; int ch = ci - row * 9; ch = ch > 7 ? 7 : ch;
        voff[k] = q < 18 ? (unsigned)(row * 3072 + ch * 8) * 2u : (q < 36 ? (unsigned)(row * NTOK + ch * 8) * 2u : 0u); }
    const char* kg0 = (const char*)(zqkf + (size_t)tokbase * 3072 + 1024 + h * 128);
    const char* vg0 = (const char*)(Vt + (size_t)(h * 128) * NTOK + tokbase);
#define AT_DMA(t, stg) do { const char* kb0_ = kg0 + (size_t)(t) * (64 * 3072 * 2); const char* vb0_ = vg0 + (size_t)(t) * 128; \
        _Pragma("unroll") for (int k = 0; k < 5; ++k) { const int q = w + 8 * k; const char* b_ = q < 9 ? kb0_ : (q < 18 ? kb0_ + 128 : (q < 36 ? vb0_ : kb0_)); \
            const int d_ = q < 36 ? (stg) * AT_STAGE + q * 1024 : 3 * AT_STAGE + (q - 36) * 1024; \
            __builtin_amdgcn_global_load_lds((const unsigned*)(b_ + voff[k]), (LAS unsigned*)(lds + d_), 16, 0, 0); } } while (0)
    AT_DMA(0, 0); if (1 < NT) AT_DMA(1, 1);
    asm volatile("s_waitcnt vmcnt(0)" ::: "memory");
    __syncthreads();
    float m_run = -INFINITY, l_run = 0.f;
    f32x16 o[4];
#pragma unroll
    for (int d = 0; d < 4; ++d)
#pragma unroll
        for (int r = 0; r < 16; ++r) o[d][r] = 0.f;
    const int kap = 16 * ((r32 >> 2) & 1) + (r32 & 3) + 4 * (r32 >> 3);
    const int qw0 = q0 + 32 * g, qpos = qw0 + r32;
    f32x16 p1; bf16x8 pw0, pw1;
    f32x16 negm; float cfold = 1e30f;
    m_run = 0.f;
#pragma unroll
    for (int r = 0; r < 16; ++r) negm[r] = 0.f;
#pragma unroll
    for (int r = 0; r < 16; ++r) p1[r] = 0.f;
    pw0 = (bf16x8){0, 0, 0, 0, 0, 0, 0, 0}; pw1 = pw0;
#define AT_BARV5() asm volatile("s_waitcnt vmcnt(5) lgkmcnt(0)\n\ts_barrier" ::: "memory")
#define AT_BARV0() asm volatile("s_waitcnt vmcnt(0) lgkmcnt(0)\n\ts_barrier" ::: "memory")
#define AT_BAR() asm volatile("s_waitcnt lgkmcnt(0)\n\ts_barrier" ::: "memory")
#define AT_X(t, STAGE_OP) do { \
        LAS const unsigned char* st_ = lds + so; LAS const unsigned char* kb_ = st_ + mp * AT_K1 + kap * AT_PITCH + hi * 16; \
        bf16x8 ka_[4], kc_[4]; \
        ka_[0] = *(const LAS bf16x8*)(kb_); ka_[1] = *(const LAS bf16x8*)(kb_ + 32 * AT_PITCH); ka_[2] = *(const LAS bf16x8*)(kb_ + 32); ka_[3] = *(const LAS bf16x8*)(kb_ + 32 * AT_PITCH + 32); \
        __builtin_amdgcn_sched_barrier(0); \
        STAGE_OP; \
        kc_[0] = *(const LAS bf16x8*)(kb_ + 64); kc_[1] = *(const LAS bf16x8*)(kb_ + 32 * AT_PITCH + 64); kc_[2] = *(const LAS bf16x8*)(kb_ + 96); kc_[3] = *(const LAS bf16x8*)(kb_ + 32 * AT_PITCH + 96); \
        __builtin_amdgcn_sched_barrier(0); \
        const int k0_ = (t) * 64; const bool farl_ = k0_ + 63 - qw0 <= -128, farr_ = k0_ - (qw0 + 31) >= 128; \
        const float c_ = farl_ ? cL : (farr_ ? cR : 0.f); \
        if (c_ != cfold) { cfold = c_; _Pragma("unroll") for (int r = 0; r < 16; ++r) negm[r] = c_ - m_run; } \
        f32x16 p0_; \
        p0_ = __builtin_amdgcn_mfma_f32_32x32x16_bf16(ka_[0], qr[0], negm, 0, 0, 0); p1 = __builtin_amdgcn_mfma_f32_32x32x16_bf16(ka_[1], qr[0], negm, 0, 0, 0); \
        p0_ = __builtin_amdgcn_mfma_f32_32x32x16_bf16(ka_[2], qr[1], p0_, 0, 0, 0); p1 = __builtin_amdgcn_mfma_f32_32x32x16_bf16(ka_[3], qr[1], p1, 0, 0, 0); \
        p0_ = __builtin_amdgcn_mfma_f32_32x32x16_bf16(kc_[0], qr[2], p0_, 0, 0, 0); p1 = __builtin_amdgcn_mfma_f32_32x32x16_bf16(kc_[1], qr[2], p1, 0, 0, 0); \
        p0_ = __builtin_amdgcn_mfma_f32_32x32x16_bf16(kc_[2], qr[3], p0_, 0, 0, 0); p1 = __builtin_amdgcn_mfma_f32_32x32x16_bf16(kc_[3], qr[3], p1, 0, 0, 0); \
        if (!farl_ && !farr_) { const int rb_ = k0_ + 16 * hi - qpos + 128; \
            _Pragma("unroll") for (int r = 0; r < 16; ++r) { const int i0 = min(max(rb_ + r, 0), 256), i1 = min(max(rb_ + 32 + r, 0), 256); \
                p0_[r] += bt[i0]; p1[r] += bt[i1]; } } \
        float tm_ = fmaxf(p0_[0], p1[0]); \
        _Pragma("unroll") for (int r = 1; r < 16; ++r) tm_ = fmaxf(tm_, fmaxf(p0_[r], p1[r])); \
        { auto rr_ = __builtin_amdgcn_permlane32_swap(__float_as_uint(tm_), __float_as_uint(tm_), false, false);     \
          tm_ = fmaxf(__uint_as_float(rr_[0]), __uint_as_float(rr_[1])); }                   \
          \
          \
        if ((t) == 0 || __any(tm_ > 8.f)) { const float dl_ = (t) == 0 ? tm_ : fmaxf(tm_, 0.f); const float al_ = (t) == 0 ? 0.f : __builtin_amdgcn_exp2f(-dl_); m_run += dl_; l_run *= al_; \
            _Pragma("unroll") for (int r = 0; r < 16; ++r) { p0_[r] -= dl_; p1[r] -= dl_; negm[r] = c_ - m_run; } \
            _Pragma("unroll") for (int d = 0; d < 4; ++d) _Pragma("unroll") for (int r = 0; r < 16; ++r) o[d][r] *= al_; } \
        float ls_ = 0.f; \
        _Pragma("unroll") for (int r = 0; r < 16; ++r) { p0_[r] = __builtin_amdgcn_exp2f(p0_[r]); ls_ += p0_[r]; } \
        l_run += ls_; \
        u32x4 a_, b_; \
        a_.x = cvtpk(p0_[0], p0_[1]); a_.y = cvtpk(p0_[2], p0_[3]); a_.z = cvtpk(p0_[4], p0_[5]); a_.w = cvtpk(p0_[6], p0_[7]); \
        b_.x = cvtpk(p0_[8], p0_[9]); b_.y = cvtpk(p0_[10], p0_[11]); b_.z = cvtpk(p0_[12], p0_[13]); b_.w = cvtpk(p0_[14], p0_[15]); \
        pw0 = __builtin_bit_cast(bf16x8, a_); pw1 = __builtin_bit_cast(bf16x8, b_); } while (0)
#define AT_VRD(dst, db) do { LAS const unsigned char* vd_ = vb_ + (db) * 32 * AT_PITCH; dst[0] = *(const LAS bf16x8*)(vd_); dst[1] = *(const LAS bf16x8*)(vd_ + 16); \
        dst[2] = *(const LAS bf16x8*)(vd_ + 64); dst[3] = *(const LAS bf16x8*)(vd_ + 80); __builtin_amdgcn_sched_barrier(0); } while (0)
#define AT_PV(f, db) do { o[db] = __builtin_amdgcn_mfma_f32_32x32x16_bf16(f[0], pw0, o[db], 0, 0, 0); o[db] = __builtin_amdgcn_mfma_f32_32x32x16_bf16(f[1], pw1, o[db], 0, 0, 0); \
        o[db] = __builtin_amdgcn_mfma_f32_32x32x16_bf16(f[2], pw2_, o[db], 0, 0, 0); o[db] = __builtin_amdgcn_mfma_f32_32x32x16_bf16(f[3], pw3_, o[db], 0, 0, 0); __builtin_amdgcn_sched_barrier(0); } while (0)
#define AT_V2(dst, i, db, off) dst[i] = *(const LAS bf16x8*)(vb_ + (db) * 32 * AT_PITCH + (off))
#define AT_E4(b) do { _Pragma("unroll") for (int r = (b); r < (b) + 4; ++r) { p1[r] = __builtin_amdgcn_exp2f(p1[r]); ls_ += p1[r]; } } while (0)
#define AT_Y(t, STAGE_OP) do { \
          \
          \
        LAS const unsigned char* vb_ = lds + so + AT_V + r32 * AT_PITCH + hi * 32; \
        bf16x8 fa_[4], fb_[4]; float ls_ = 0.f; \
        AT_V2(fa_, 0, 0, 0); AT_V2(fa_, 1, 0, 16); AT_V2(fa_, 2, 1, 0); AT_V2(fa_, 3, 1, 16); __builtin_amdgcn_sched_barrier(0); \
        STAGE_OP; \
        AT_V2(fb_, 0, 2, 0); AT_V2(fb_, 1, 2, 16); AT_V2(fb_, 2, 3, 0); AT_V2(fb_, 3, 3, 16); __builtin_amdgcn_sched_barrier(0); \
        o[0] = __builtin_amdgcn_mfma_f32_32x32x16_bf16(fa_[0], pw0, o[0], 0, 0, 0); o[1] = __builtin_amdgcn_mfma_f32_32x32x16_bf16(fa_[2], pw0, o[1], 0, 0, 0); AT_E4(0); __builtin_amdgcn_sched_barrier(0); \
        o[0] = __builtin_amdgcn_mfma_f32_32x32x16_bf16(fa_[1], pw1, o[0], 0, 0, 0); o[1] = __builtin_amdgcn_mfma_f32_32x32x16_bf16(fa_[3], pw1, o[1], 0, 0, 0); AT_E4(4); __builtin_amdgcn_sched_barrier(0); \
        AT_V2(fa_, 0, 0, 64); AT_V2(fa_, 1, 0, 80); AT_V2(fa_, 2, 1, 64); AT_V2(fa_, 3, 1, 80); __builtin_amdgcn_sched_barrier(0); \
        o[2] = __builtin_amdgcn_mfma_f32_32x32x16_bf16(fb_[0], pw0, o[2], 0, 0, 0); o[3] = __builtin_amdgcn_mfma_f32_32x32x16_bf16(fb_[2], pw0, o[3], 0, 0, 0); AT_E4(8); __builtin_amdgcn_sched_barrier(0); \
        o[2] = __builtin_amdgcn_mfma_f32_32x32x16_bf16(fb_[1], pw1, o[2], 0, 0, 0); o[3] = __builtin_amdgcn_mfma_f32_32x32x16_bf16(fb_[3], pw1, o[3], 0, 0, 0); AT_E4(12); \
        l_run += ls_; \
        u32x4 c2_, d2_; \
        c2_.x = cvtpk(p1[0], p1[1]); c2_.y = cvtpk(p1[2], p1[3]); c2_.z = cvtpk(p1[4], p1[5]); c2_.w = cvtpk(p1[6], p1[7]); \
        d2_.x = cvtpk(p1[8], p1[9]); d2_.y = cvtpk(p1[10], p1[11]); d2_.z = cvtpk(p1[12], p1[13]); d2_.w = cvtpk(p1[14], p1[15]); \
        const bf16x8 pw2_ = __builtin_bit_cast(bf16x8, c2_), pw3_ = __builtin_bit_cast(bf16x8, d2_); __builtin_amdgcn_sched_barrier(0); \
        AT_V2(fb_, 0, 2, 64); AT_V2(fb_, 1, 2, 80); AT_V2(fb_, 2, 3, 64); AT_V2(fb_, 3, 3, 80); __builtin_amdgcn_sched_barrier(0); \
        o[0] = __builtin_amdgcn_mfma_f32_32x32x16_bf16(fa_[0], pw2_, o[0], 0, 0, 0); o[1] = __builtin_amdgcn_mfma_f32_32x32x16_bf16(fa_[2], pw2_, o[1], 0, 0, 0); \
        o[0] = __builtin_amdgcn_mfma_f32_32x32x16_bf16(fa_[1], pw3_, o[0], 0, 0, 0); o[1] = __builtin_amdgcn_mfma_f32_32x32x16_bf16(fa_[3], pw3_, o[1], 0, 0, 0); __builtin_amdgcn_sched_barrier(0); \
        o[2] = __builtin_amdgcn_mfma_f32_32x32x16_bf16(fb_[0], pw2_, o[2], 0, 0, 0); o[3] = __builtin_amdgcn_mfma_f32_32x32x16_bf16(fb_[2], pw2_, o[3], 0, 0, 0); \
        o[2] = __builtin_amdgcn_mfma_f32_32x32x16_bf16(fb_[1], pw3_, o[2], 0, 0, 0); o[3] = __builtin_amdgcn_mfma_f32_32x32x16_bf16(fb_[3], pw3_, o[3], 0, 0, 0); __builtin_amdgcn_sched_barrier(0); } while (0)
    int so = 0, s2 = 2;
    if (mp == 0) {
        for (int t = 0; t < NT; ++t) {
            AT_X(t, (void)0); AT_BAR();
            AT_Y(t, if (t + 2 < NT) AT_DMA(t + 2, s2)); if (t + 2 < NT) AT_BARV5(); else AT_BARV0();
            so = so == 2 * AT_STAGE ? 0 : so + AT_STAGE; s2 = s2 == 2 ? 0 : s2 + 1;
        }
        AT_BAR();
    } else {
        AT_BAR();
        for (int t = 0; t < NT; ++t) {
            AT_X(t, if (t + 2 < NT) AT_DMA(t + 2, s2)); if (t + 2 < NT) AT_BARV5(); else AT_BARV0();
            AT_Y(t, (void)0); AT_BAR();
            so = so == 2 * AT_STAGE ? 0 : so + AT_STAGE; s2 = s2 == 2 ? 0 : s2 + 1;
        }
    }
#undef AT_X
#undef AT_Y
#undef AT_VRD
#undef AT_PV
#undef AT_V2
#undef AT_E4
#undef AT_BAR
#undef AT_BARV5
#undef AT_BARV0
#undef AT_DMA
    l_run += __shfl_xor(l_run, 32);
    const float inv = 1.f / l_run;
    LAS float* X = (LAS float*)lds + g * 4096;
    if (mp == 1) { const float f = inv * lam;
#pragma unroll
        for (int d = 0; d < 4; ++d)
#pragma unroll
            for (int r = 0; r < 16; ++r) X[(d * 16 + r) * 64 + lane] = o[d][r] * f; }
    __syncthreads();
    if (mp == 0) {
        float ss = 0.f;
#pragma unroll
        for (int d = 0; d < 4; ++d)
#pragma unroll
            for (int r = 0; r < 16; ++r) { const float v = o[d][r] * inv - X[(d * 16 + r) * 64 + lane]; o[d][r] = v; ss += v * v; }
        ss += __shfl_xor(ss, 32);
        const float rs = __builtin_amdgcn_rsqf(ss * (1.f / 128.f) + EPS) * oscale;
        bf16_t* op = cat + (size_t)(tokbase + qpos) * DM + h * 128 + 4 * hi;
#pragma unroll
        for (int d = 0; d < 4; ++d)
#pragma unroll
            for (int rq = 0; rq < 4; ++rq) { const int dv = 32 * d + 8 * rq; const f32x4 gn = *(const f32x4*)(subln + dv + 4 * hi);
                u32x2 wv; wv.x = cvtpk(o[d][4 * rq] * rs * gn[0], o[d][4 * rq + 1] * rs * gn[1]); wv.y = cvtpk(o[d][4 * rq + 2] * rs * gn[2], o[d][4 * rq + 3] * rs * gn[3]);
                *(u32x2*)(op + dv) = wv; }
    }
    __syncthreads();
}

__device__ __forceinline__ void row_pass0(const float* xin, bf16_t* hrow, rss_t* rss, int lane) {
    float s2 = 0.f;
#pragma unroll
    for (int j = 0; j < 4; ++j) { const int c = 8 * (lane + 64 * j);
        const f32x4 a = *(const f32x4*)(xin + c), b = *(const f32x4*)(xin + c + 4);
        u32x4 w; w.x = cvtpk(a[0], a[1]); w.y = cvtpk(a[2], a[3]); w.z = cvtpk(b[0], b[1]); w.w = cvtpk(b[2], b[3]);
        *(u32x4*)(hrow + c) = w;
#pragma unroll
        for (int e = 0; e < 4; ++e) { const float lo = bflo(w[e]), hi = bfhi(w[e]); s2 += lo * lo + hi * hi; } }
    s2 = wave_sum(s2);
    if (lane == 0) *rss = (rss_t)(s2 * RSS_FX + 0.5f);
}

__device__ __forceinline__ void conv_job(const float* W, const float* gk, int ldw, int Krows, int n_begin, int ncols, bf16_t* WT, int row_off, int ilv, LAS float* scr, int gw, int NGW, int lane) {
    (void)scr;
    const int nblk = ncols / 64, nitems = (Krows / 32) * nblk;
    for (int it = gw; it < nitems; it += NGW) {
        const int kb = it / nblk, nb = it % nblk, k0 = 32 * kb, j = 64 * nb + lane;
        const float* wp = W + (size_t)k0 * ldw + n_begin + j;
        float v[32];
#pragma unroll
        for (int i = 0; i < 32; ++i) v[i] = wp[(size_t)i * ldw];
        if (gk) {
#pragma unroll
            for (int i = 0; i < 32; ++i) v[i] *= gk[k0 + i];
        }
        const int dr = row_off + (ilv < 0 ? j : ((j >> 7) * 256 + ilv * 128 + (j & 127)));
        bf16_t* dp = WT + (size_t)dr * Krows + k0;
#pragma unroll
        for (int c = 0; c < 4; ++c) { u32x4 o; o.x = cvtpk(v[8 * c], v[8 * c + 1]); o.y = cvtpk(v[8 * c + 2], v[8 * c + 3]); o.z = cvtpk(v[8 * c + 4], v[8 * c + 5]); o.w = cvtpk(v[8 * c + 6], v[8 * c + 7]);
            *(u32x4*)(dp + 8 * c) = o; }
    }
}

__device__ __forceinline__ int rel_bucket(int rel) {
    const int n = rel < 0 ? -rel : rel; int b;
    if (n < 8) b = n; else b = 8 + (n >= 12) + (n >= 16) + (n >= 23) + (n >= 32) + (n >= 46) + (n >= 64) + (n >= 91);
    return (rel > 0 ? 16 : 0) + b;
}


#define XB_TMO      128
#define XB_XCNT(j)  (256  + 64 * (j))
#define XB_XSUB(j)  (1280 + 64 * (j))
#define XB_XGEN(j)  (2304 + 64 * (j))
#define XB_TOP      3328
#define XB_TOPGEN   3392
#define XCD_BAR_WORDS 3456
#define XB_SPIN_CAP (1u << 22)
__device__ __forceinline__ unsigned xb_ld(unsigned* p)              { return __hip_atomic_load(p, __ATOMIC_RELAXED, __HIP_MEMORY_SCOPE_AGENT); }
__device__ __forceinline__ unsigned xb_add(unsigned* p, unsigned v) { return __hip_atomic_fetch_add(p, v, __ATOMIC_RELAXED, __HIP_MEMORY_SCOPE_AGENT); }
__device__ __forceinline__ unsigned xb_xcc_id() { return (unsigned)__builtin_amdgcn_s_getreg((3 << 11) | 20) & 0xFu; }
#define XB_SPIN(cond, bar) do { unsigned _sp = 0; while (cond) { __builtin_amdgcn_s_sleep(1); \
    if ((++_sp & 255u) == 0u) { if (xb_ld(&(bar)[XB_TMO])) break; if (_sp > XB_SPIN_CAP) { atomicAdd(&(bar)[XB_TMO], 1u); break; } } } } while (0)
__device__ __forceinline__ void xcd_barrier_complete(unsigned* bar, unsigned x, unsigned& nloc, unsigned& nx) {
    const unsigned G = gridDim.x * gridDim.y * gridDim.z;
    unsigned sum, cnt, mine, sp = 0u;
    for (;;) {
        sum = 0u; cnt = 0u; mine = 0u;
#pragma unroll
        for (unsigned j = 0; j < 16; ++j) { const unsigned c = xb_ld(&bar[XB_XCNT(j)]); sum += c; cnt += (c > 0u) ? 1u : 0u; mine = (j == x) ? c : mine; }
        if (sum == G) break;
        __builtin_amdgcn_s_sleep(1);
        if ((++sp & 255u) == 0u) { if (xb_ld(&bar[XB_TMO])) break; if (sp > XB_SPIN_CAP) { atomicAdd(&bar[XB_TMO], 1u); break; } }
    }
    nloc = mine > 0u ? mine : 1u; nx = cnt > 0u ? cnt : 1u;
}
__device__ __forceinline__ void xcd_barrier(unsigned* bar, volatile LAS unsigned* st) {
    asm volatile("s_waitcnt vmcnt(0)" ::: "memory");
    __syncthreads();
    if (threadIdx.x == 0) {
        const unsigned x = xb_xcc_id();
        __builtin_amdgcn_s_waitcnt(0);
        unsigned nloc = st[0], nx = st[1];
        if (nloc == 0u) { xcd_barrier_complete(bar, x, nloc, nx); st[0] = nloc; st[1] = nx; }
        const unsigned old = xb_add(&bar[XB_XSUB(x)], 1u);
        const unsigned gen = old / nloc;
        if (old + 1u == (gen + 1u) * nloc) {
            __builtin_amdgcn_fence(__ATOMIC_RELEASE, "agent");
            asm volatile("s_waitcnt vmcnt(0)" ::: "memory");
            const unsigned og = xb_add(&bar[XB_TOP], 1u);
            const unsigned tg = og / nx;
            if (og + 1u == (tg + 1u) * nx) xb_add(&bar[XB_TOPGEN], 1u);
            else XB_SPIN(xb_ld(&bar[XB_TOPGEN]) == tg, bar);
            __builtin_amdgcn_fence(__ATOMIC_ACQUIRE, "agent");
            xb_add(&bar[XB_XGEN(x)], 1u);
            asm volatile("s_waitcnt vmcnt(0)" ::: "memory");
        } else {
            XB_SPIN(xb_ld(&bar[XB_XGEN(x)]) == gen, bar);
            __builtin_amdgcn_fence(__ATOMIC_ACQUIRE, "agent");
            asm volatile("s_waitcnt vmcnt(0)" ::: "memory");
        }
    }
    __syncthreads();
}

struct Args { const float* in[22]; float* out; unsigned char* ws; int ph_lo, ph_hi; };
enum { I_XP = 0, I_XS, I_RELB, I_NPRE_MIX, I_NPOST_MIX, I_NPRE_FFN, I_NPOST_FFN, I_AB_WIN, I_AB_WOUT, I_LQ1, I_LK1, I_LQ2, I_LK2, I_SUBLN,
       I_C_WIN, I_C_CONV, I_C_WOUT, I_F_WG, I_F_WU, I_F_CONV, I_F_CONVB, I_F_WD };

__global__ void __launch_bounds__(512, 2) mk_fwd(Args args_unused) {
    extern __shared__ __attribute__((aligned(16))) unsigned char lds_raw[];
    typedef const __attribute__((address_space(4))) Args* KArgsP;
#define KARGS KArgsP A; { auto ka_ = __builtin_amdgcn_kernarg_segment_ptr(); asm volatile("" : "+s"(ka_)); A = (KArgsP)ka_; } \
    LAS unsigned char* lds = (LAS unsigned char*)lds_raw; \
    int tid = threadIdx.x; asm volatile("" : "+v"(tid)); const int lane = tid & 63, wave = __builtin_amdgcn_readfirstlane(tid >> 6); \
    const int G = gridDim.x, bx = blockIdx.x; const int vcu = (G % 8 == 0) ? (bx % 8) * (G / 8) + bx / 8 : bx; const int gw = vcu * 8 + wave, NGW = G * 8; \
    unsigned char* ws = A->ws; float* xres = A->out; bf16_t* H = (bf16_t*)(ws + WS_H); unsigned char* WBM = ws + WS_WB; unsigned char* WBF = ws + WS_WB1; unsigned char* SCR = ws + WS_SCR; \
    float* biasT = (float*)(ws + WS_CTL); LAS float* scr = (LAS float*)(lds + wave * 16384); \
    (void)lane; (void)gw; (void)NGW; (void)xres; (void)H; (void)WBM; (void)WBF; (void)SCR; (void)biasT; (void)scr; (void)vcu; (void)bx
    int lo, hi;
    { KArgsP A0; { auto ka_ = __builtin_amdgcn_kernarg_segment_ptr(); A0 = (KArgsP)ka_; } lo = A0->ph_lo; hi = A0->ph_hi; }
    if (lo < 0) cg::this_grid().sync();
    { volatile LAS unsigned* st_ = (volatile LAS unsigned*)((LAS unsigned char*)lds_raw + LDS_MISC); if (threadIdx.x < 2) st_[threadIdx.x] = 0u; __syncthreads();
      if (hi - lo > 1 && threadIdx.x == 0) { KArgsP A1; { auto ka_ = __builtin_amdgcn_kernarg_segment_ptr(); A1 = (KArgsP)ka_; } (void)xb_add((unsigned*)(A1->ws + WS_BAR) + XB_XCNT(xb_xcc_id()), 1u); } }
    int ph = 0;
#define PH_ON (ph >= lo && ph < hi)
#define PH_END do { if (ph >= lo && ph + 1 < hi) { unsigned* bar_; { auto ka_ = __builtin_amdgcn_kernarg_segment_ptr(); asm volatile("" : "+s"(ka_)); bar_ = (unsigned*)(((KArgsP)ka_)->ws + WS_BAR); } \
        xcd_barrier(bar_, (volatile LAS unsigned*)((LAS unsigned char*)lds_raw + LDS_MISC)); } ++ph; } while (0)

#define CONV_AB(j) do { const float* win_ = A->in[I_AB_WIN] + (size_t)(j) * DM * 4096; const float* wout_ = A->in[I_AB_WOUT] + (size_t)(j) * DM * DM; \
        conv_job(win_, A->in[I_NPRE_MIX] + 2 * (j) * DM, 4096, DM, 0, 2048, (bf16_t*)(WBM + WB_QKF), 0, -1, scr, gw, NGW, lane); \
        conv_job(win_, A->in[I_NPRE_MIX] + 2 * (j) * DM, 4096, DM, 3072, 1024, (bf16_t*)(WBM + WB_QKF), 2048, -1, scr, gw, NGW, lane); \
        conv_job(win_, A->in[I_NPRE_MIX] + 2 * (j) * DM, 4096, DM, 2048, 1024, (bf16_t*)(WBM + WB_V), 0, -1, scr, gw, NGW, lane); \
        conv_job(wout_, nullptr, DM, DM, 0, DM, (bf16_t*)(WBM + WB_OUT), 0, -1, scr, gw, NGW, lane); } while (0)
#define CONV_C(j) do { const float* win_ = A->in[I_C_WIN] + (size_t)(j) * DM * 6144; const float* wout_ = A->in[I_C_WOUT] + (size_t)(j) * DM * DM; \
        conv_job(win_, A->in[I_NPRE_MIX] + (2 * (j) + 1) * DM, 6144, DM, 0, 2048, (bf16_t*)(WBM + WB_CB), 0, -1, scr, gw, NGW, lane); \
        conv_job(win_, A->in[I_NPRE_MIX] + (2 * (j) + 1) * DM, 6144, DM, 2048, 2048, (bf16_t*)(WBM + WB_CX), 0, 0, scr, gw, NGW, lane); \
        conv_job(win_, A->in[I_NPRE_MIX] + (2 * (j) + 1) * DM, 6144, DM, 4096, 2048, (bf16_t*)(WBM + WB_CX), 0, 1, scr, gw, NGW, lane); \
        conv_job(wout_, nullptr, DM, DM, 0, DM, (bf16_t*)(WBM + WB_COUT), 0, -1, scr, gw, NGW, lane); } while (0)
#define CONV_FFN(i) do { \
        conv_job(A->in[I_F_WG] + (size_t)(i) * DM * DFF, A->in[I_NPRE_FFN] + (i) * DM, DFF, DM, 0, DFF, (bf16_t*)(WBF + WB_G), 0, -1, scr, gw, NGW, lane); \
        conv_job(A->in[I_F_WU] + (size_t)(i) * DM * DFF, A->in[I_NPRE_FFN] + (i) * DM, DFF, DM, 0, DFF, (bf16_t*)(WBF + WB_U), 0, -1, scr, gw, NGW, lane); \
        conv_job(A->in[I_F_WD] + (size_t)(i) * DFF * DM, nullptr, DM, DFF, 0, DM, (bf16_t*)(WBF + WB_D), 0, -1, scr, gw, NGW, lane); } while (0)

#define FUSED_OUT(Aptr, Bptr, KK, q_, gpost_, last_, rin_) do { \
        __syncthreads(); \
        pg8::ProbPanel P{(const char*)(Aptr), (const char*)(Bptr), (KK), (KK), (KK), bx}; \
        unsigned* cb_ = (unsigned*)(ws + WS_CNT) + (size_t)(q_) * 2 * 96 * 16; \
        pg8::EpiNormRes E{H, (last_) ? xres : (float*)nullptr, (gpost_), (rss_t*)(ws + WS_RSS) + (size_t)((q_) + 1 < 8 ? (q_) + 1 : 0) * NTOK, (rin_), (float*)(ws + WS_X1), cb_, (unsigned*)(ws + WS_BAR) + XB_TMO, lds + LDS_EPI}; \
        pg8::gemm_phase(lds, P, E); } while (0)
    if (PH_ON) { KARGS;
        for (int m = gw; m < NTOK; m += NGW) {
            const float* xin = m < NTOK_P ? A->in[I_XP] + (size_t)m * DM : A->in[I_XS] + (size_t)(m - NTOK_P) * DM;
            row_pass0(xin, H + (size_t)m * DM, (rss_t*)(ws + WS_RSS) + m, lane);
        }
        CONV_AB(0);
        if (bx == 0 && tid < 2) { const int jj = tid; float d1 = 0.f, d2 = 0.f;
            for (int i = 0; i < 64; ++i) { d1 += A->in[I_LQ1][jj * 64 + i] * A->in[I_LK1][jj * 64 + i]; d2 += A->in[I_LQ2][jj * 64 + i] * A->in[I_LK2][jj * 64 + i]; }
            const float li = 0.8f - 0.6f * expf(-0.3f * (float)(2 * jj));
            biasT[8 * 260 + 2 * jj] = expf(d1) - expf(d2) + li; biasT[8 * 260 + 2 * jj + 1] = li; }
        for (int i = bx * 512 + tid; i < 8 * 257; i += G * 512) { const int h = i / 257, idx = i % 257; biasT[h * 260 + idx] = A->in[I_RELB][rel_bucket(idx - 128) * 8 + h] * LOG2E; }
        { bf16_t* dc = (bf16_t*)(ws + WS_DFTC);
          for (int i = bx * 512 + tid; i < 512 * 256 / 8; i += G * 512) { const int r = i / 32, c0 = (i % 32) * 8, cp = r & 255; float v[8];
#pragma unroll
              for (int e = 0; e < 8; ++e) { const float ph_ = (float)((cp * (c0 + e)) & 255) * (1.f / 256.f); v[e] = (r >> 8 ? __builtin_amdgcn_sinf(ph_) : __builtin_amdgcn_cosf(ph_)) * 0.0625f; }
              u32x4 w; w.x = cvtpk(v[0], v[1]); w.y = cvtpk(v[2], v[3]); w.z = cvtpk(v[4], v[5]); w.w = cvtpk(v[6], v[7]); *(u32x4*)(dc + (size_t)r * 256 + c0) = w; } }
#pragma unroll 1
        for (int which = 0; which < 2; ++which) {
            const int S = which ? SEQ_S : SEQ_P; bf16_t* cs = (bf16_t*)(ws + (which ? WS_CS2 : WS_CS4)); const float nrm = which ? 0.022097086912079608f : 0.015625f, invS = 1.f / (float)S;
            const int per_row = 2 * S / 8, total = S * per_row;
            for (int i = bx * 512 + tid; i < total; i += G * 512) { const int r = i / per_row, k0 = (i % per_row) * 8; const bool sn = k0 >= S; const int kk = sn ? k0 - S : k0; float v[8];
#pragma unroll
                for (int e = 0; e < 8; ++e) { const float ph_ = (float)((r * (kk + e)) & (S - 1)) * invS; v[e] = sn ? -__builtin_amdgcn_sinf(ph_) * nrm : __builtin_amdgcn_cosf(ph_) * nrm; }
                u32x4 w; w.x = cvtpk(v[0], v[1]); w.y = cvtpk(v[2], v[3]); w.z = cvtpk(v[4], v[5]); w.w = cvtpk(v[6], v[7]); *(u32x4*)(cs + (size_t)r * 2 * S + k0) = w; }
        }
    }
    PH_END;

#pragma unroll 1
    for (int layer = 0; layer < NLAYER; ++layer) {
        const int j = layer >> 1;
        if ((layer & 1) == 0) {
#define AB_PTRS bf16_t* zqkf = (bf16_t*)(SCR + SC_ZQKF); bf16_t* vt = (bf16_t*)(SCR + SC_VT); bf16_t* cat = (bf16_t*)(SCR + SC_CAT); bf16_t* yt = (bf16_t*)(SCR + SC_YT); \
        bf16_t* Mbuf = (bf16_t*)(SCR + SC_ABM); (void)zqkf; (void)vt; (void)cat; (void)yt; (void)Mbuf
            if (PH_ON) { KARGS; AB_PTRS;
                pg8::ProbAB1 P{(const char*)H, (const char*)(WBM + WB_QKF), (const char*)(WBM + WB_V), DM, DM, DM, G, bx};
                pg8::EpiStore<pg8::AddrAB1> E{{zqkf, vt, (const rss_t*)(ws + WS_RSS) + (size_t)(2 * layer) * NTOK}};
                pg8::gemm_phase(lds, P, E);
            }
            PH_END;
            if (PH_ON) { KARGS; AB_PTRS;
                pg8::ProbF1 P{(const char*)(ws + WS_DFTC), (const char*)(zqkf + 2048), 256, 256, 3072, G, bx};
                pg8::EpiStore<pg8::AddrF1> E{{yt}};
                pg8::gemm_phase(lds, P, E);
            }
            PH_END;
            if (PH_ON) { KARGS; AB_PTRS;
                const float lam = biasT[8 * 260 + 2 * j], lam_init = biasT[8 * 260 + 2 * j + 1];
                const float* subln = A->in[I_SUBLN] + j * 128;
#ifdef PROBE_ATTN2
                for (int rep_ = 0; rep_ < 2; ++rep_) {
#else
                {
#endif
                for (int u = vcu; u < 512; u += G) { const int bh = u >> 5, qb = u & 31;
                    attn_unit(lds, zqkf, vt, cat, biasT, subln, lam, 1.f - lam_init, (bh >> 3) * SEQ_P, SEQ_P, bh & 7, qb * 128); }
                for (int u = vcu; u < 1024; u += G) { const int bh = u >> 4, qb = u & 15;
                    attn_unit(lds, zqkf, vt, cat, biasT, subln, lam, 1.f - lam_init, NTOK_P + (bh >> 3) * SEQ_S, SEQ_S, bh & 7, qb * 128); }
                }
                {
                    int firstP, cntP, firstS, cntS;
                    if (G == 256) { firstP = vcu; cntP = vcu < 128 ? 1 : 0; firstS = (vcu - 128) * 2; cntS = vcu >= 128 ? 2 : 0; }
                    else { const int per = (128 + G - 1) / G; firstP = vcu * per; cntP = firstP >= 128 ? 0 : (128 - firstP < per ? 128 - firstP : per);
                           const int per2 = (256 + G - 1) / G; firstS = vcu * per2; cntS = firstS >= 256 ? 0 : (256 - firstS < per2 ? 256 - firstS : per2); }
                    pg8::ProbF2 PP{(const char*)(ws + WS_CS4), (const char*)yt, 2 * SEQ_P, 2 * SEQ_P, 2 * 2 * SEQ_P, 2, 16, firstP, cntP};
                    pg8::EpiStore<pg8::AddrF2> EP{{cat, 0, SEQ_P}};
                    pg8::gemm_phase(lds, PP, EP);
                    pg8::ProbF2 PS{(const char*)(ws + WS_CS2), (const char*)yt + YT_S_OFF, 2 * SEQ_S, 2 * SEQ_S, 8 * 2 * SEQ_S, 8, 8, firstS, cntS};
                    pg8::EpiStore<pg8::AddrF2> ES{{cat, NTOK_P, SEQ_S}};
                    pg8::gemm_phase(lds, PS, ES);
                }
            }
            PH_END;
            if (PH_ON) { KARGS; AB_PTRS;
                CONV_FFN(layer);
                FUSED_OUT(cat, WBM + WB_OUT, DM, 2 * layer, A->in[I_NPOST_MIX] + layer * DM, false, (const rss_t*)nullptr);
            }
            PH_END;
        } else {
#define C_PTRS bf16_t* pbuf = (bf16_t*)(SCR + SC_P); bf16_t* ubuf = (bf16_t*)(SCR + SC_U); bf16_t* Mbuf = (bf16_t*)(SCR + SC_CM); (void)pbuf; (void)ubuf; (void)Mbuf
            if (PH_ON) { KARGS; C_PTRS;
                pg8::ProbSimple P{(const char*)H, (const char*)(WBM + WB_CX), DM, DM, DM, NTOK / 256, 4096 / 256, G, bx};
                pg8::EpiMulHalves E{pbuf, DM, (const rss_t*)(ws + WS_RSS) + (size_t)(2 * layer) * NTOK};
                pg8::gemm_phase(lds, P, E);
            }
            PH_END;
            if (PH_ON) { KARGS; C_PTRS;
                pg8::ProbSimple P{(const char*)H, (const char*)(WBM + WB_CB), DM, DM, DM, NTOK / 256, DM / 256, G, bx};
                pg8::EpiConvMul<false> E{pbuf, ubuf, A->in[I_C_CONV] + (size_t)j * 3 * DM, nullptr, DM, nullptr, 0u, nullptr, lds + LDS_EPI};
                pg8::gemm_phase(lds, P, E);
            }
            PH_END;
            if (PH_ON) { KARGS; C_PTRS;
                CONV_FFN(layer);
                FUSED_OUT(ubuf, WBM + WB_COUT, DM, 2 * layer, A->in[I_NPOST_MIX] + layer * DM, false, (const rss_t*)(ws + WS_RSS) + (size_t)(2 * layer) * NTOK);
            }
            PH_END;
        }
#define F_PTRS bf16_t* gate = (bf16_t*)(SCR + SC_GATE); bf16_t* act = (bf16_t*)(SCR + SC_ACT); bf16_t* fm = (bf16_t*)(SCR + SC_FM); (void)gate; (void)act; (void)fm
        if (PH_ON) { KARGS; F_PTRS;
          {
            bf16_t* upraw = (bf16_t*)(WBM + 34 * MiB);
            pg8::ProbF1G P{(const char*)H, (const char*)(WBF + WB_G), (const char*)(WBF + WB_U), DM, DM, DM, G, bx};
            pg8::EpiStore<pg8::AddrF1G> E{{gate, upraw, (const rss_t*)(ws + WS_RSS) + (size_t)(2 * layer + 1) * NTOK}};
            pg8::gemm_phase(lds, P, E);
          }
          unsigned* hc = (unsigned*)(ws + WS_BAR) + 3520 + layer * 16;
          asm volatile("s_waitcnt vmcnt(0)" ::: "memory"); __syncthreads();
          if (tid == 0) { *(volatile LAS unsigned*)(lds + LDS_EPI + 5120) = 0u; __builtin_amdgcn_fence(__ATOMIC_RELEASE, "agent"); asm volatile("s_waitcnt vmcnt(0)" ::: "memory"); (void)xb_add(hc, 1u); }
          __syncthreads();
          {
            pg8::ProbSimple P{(const char*)H, (const char*)(WBF + WB_U), DM, DM, DM, NTOK / 256, 20, G, bx};
            pg8::EpiConvMul<true> E{gate, act, A->in[I_F_CONV] + (size_t)layer * 3 * DFF, A->in[I_F_CONVB] + (size_t)layer * DFF, DFF, hc, (unsigned)G, (unsigned*)(ws + WS_BAR) + XB_TMO, lds + LDS_EPI};
            pg8::gemm_phase(lds, P, E);
            const int nfull = (96 * 20) / G, rem = 96 * 20 - nfull * G;
            if (bx >= rem) {
                const bf16_t* upraw = (const bf16_t*)(WBM + 34 * MiB);
                const float* cw = A->in[I_F_CONV] + (size_t)layer * 3 * DFF; const float* cb = A->in[I_F_CONVB] + (size_t)layer * DFF;
                const int nth = (G - rem) * 512, t0 = (bx - rem) * 512 + tid;
                for (int idx = t0; idx < NTOK * 64; idx += nth) {
                    const int row = idx >> 6, c0 = 5120 + (idx & 63) * 8;
                    const int smask = row < NTOK_P ? (SEQ_P - 1) : (SEQ_S - 1);
                    const bool hp = (row & smask) != 0, hn = (row & smask) != smask;
                    const bf16_t* sp = gate + (size_t)row * DFF + c0;
                    const u32x4 cu = *(const u32x4*)sp; u32x4 pv = *(const u32x4*)(hp ? sp - DFF : sp), nx = *(const u32x4*)(hn ? sp + DFF : sp);
                    if (!hp) pv = (u32x4){0u, 0u, 0u, 0u}; if (!hn) nx = (u32x4){0u, 0u, 0u, 0u};
                    const u32x4 up = *(const u32x4*)(upraw + (size_t)row * 512 + (c0 - 5120));
                    float r[8];
#pragma unroll
                    for (int e = 0; e < 4; ++e) {
                        const f32x2_t w0 = *(const f32x2_t*)(cw + c0 + 2 * e), w1 = *(const f32x2_t*)(cw + DFF + c0 + 2 * e), w2 = *(const f32x2_t*)(cw + 2 * DFF + c0 + 2 * e), bb = *(const f32x2_t*)(cb + c0 + 2 * e);
                        float g0 = w0[0] * bflo(pv[e]) + w1[0] * bflo(cu[e]) + w2[0] * bflo(nx[e]) + bb[0];
                        float g1 = w0[1] * bfhi(pv[e]) + w1[1] * bfhi(cu[e]) + w2[1] * bfhi(nx[e]) + bb[1];
                        g0 = g0 * __builtin_amdgcn_rcpf(1.f + __builtin_amdgcn_exp2f(-g0 * LOG2E)); g1 = g1 * __builtin_amdgcn_rcpf(1.f + __builtin_amdgcn_exp2f(-g1 * LOG2E));
                        r[2 * e] = g0 * bflo(up[e]); r[2 * e + 1] = g1 * bfhi(up[e]); }
                    u32x4 w; w.x = cvtpk(r[0], r[1]); w.y = cvtpk(r[2], r[3]); w.z = cvtpk(r[4], r[5]); w.w = cvtpk(r[6], r[7]);
                    *(u32x4*)(act + (size_t)row * DFF + c0) = w;
                }
            }
          }
        }
        PH_END;
        if (PH_ON) { KARGS; F_PTRS;
            const bool lastl = layer == NLAYER - 1;
            if (!lastl) { if (((layer + 1) & 1) == 0) CONV_AB((layer + 1) >> 1); else CONV_C((layer + 1) >> 1); }
            FUSED_OUT(act, WBF + WB_D, DFF, 2 * layer + 1, A->in[I_NPOST_FFN] + layer * DM, lastl, (const rss_t*)(ws + WS_RSS) + (size_t)(2 * layer + 1) * NTOK);
        }
        PH_END;
    }
}
constexpr int N_PHASES = 1 + 2 * (4 + 2) + 2 * (3 + 2);

extern "C" void kernel_launch(void* const* d_in, const int* in_sizes, int n_in, void* d_out, int out_size, void* d_ws, size_t ws_size, hipStream_t stream) {
    static int grid = 0;
    if (grid == 0) {
        if (n_in != 22 || out_size != NTOK * DM || ws_size < WS_END) { fprintf(stderr, "kernel_launch: unexpected shapes (n_in %d out %d ws %zu)\n", n_in, out_size, ws_size); grid = -1; return; }
        int dev = 0, cus = 0, per_cu = 0;
        hipGetDevice(&dev); hipDeviceGetAttribute(&cus, hipDeviceAttributeMultiprocessorCount, dev);
        if (hipFuncSetAttribute((const void*)mk_fwd, hipFuncAttributeMaxDynamicSharedMemorySize, LDS_BYTES) != hipSuccess) { fprintf(stderr, "kernel_launch: hipFuncSetAttribute failed\n"); grid = -1; return; }
        if (hipOccupancyMaxActiveBlocksPerMultiprocessor(&per_cu, (const void*)mk_fwd, 512, LDS_BYTES) != hipSuccess || per_cu < 1) { fprintf(stderr, "kernel_launch: occupancy query says %d\n", per_cu); per_cu = 1; }
        (void)hipGetLastError();
        grid = cus;
        if (grid != 256) { fprintf(stderr, "kernel_launch: built for a 256-CU device (got %d)\n", cus); grid = -1; return; }
    }
    if (grid < 0) return;
    Args a{};
    for (int i = 0; i < 22; ++i) a.in[i] = (const float*)d_in[i];
    a.out = (float*)d_out; a.ws = (unsigned char*)d_ws;
#if MK_ONE_LAUNCH
    if (hipMemsetAsync((char*)d_ws + ZERO_OFF, 0, ZERO_BYTES, stream) != hipSuccess) { fprintf(stderr, "kernel_launch: memset failed\n"); return; }
    static_assert(WS_RSS + RSS_BYTES <= ZERO_OFF + ZERO_BYTES && WS_RSS >= ZERO_OFF, "row sums inside the zeroed region");
    a.ph_lo = 0; a.ph_hi = N_PHASES;
    void* params[] = {&a};
    hipError_t e = hipLaunchCooperativeKernel((const void*)mk_fwd, dim3(grid), dim3(512), params, LDS_BYTES, stream);
    if (e != hipSuccess) fprintf(stderr, "kernel_launch: cooperative launch failed: %s (grid %d)\n", hipGetErrorString(e), grid);
#else
    for (int p = 0; p < N_PHASES; ++p) {
        a.ph_lo = p; a.ph_hi = p + 1;
        hipLaunchKernelGGL(mk_fwd, dim3(grid), dim3(512), LDS_BYTES, stream, a);
    }
#endif
}
```

```cpp
#include <hip/hip_runtime.h>
#include <hip/hip_cooperative_groups.h>
#include <cstdio>
#include <cstdint>
namespace cg = cooperative_groups;

#ifndef MK_ONE_LAUNCH
#define MK_ONE_LAUNCH 1
#endif

#define LAS __attribute__((address_space(3)))
typedef unsigned short bf16_t;
typedef short bf16x8 __attribute__((ext_vector_type(8)));
typedef float f32x4 __attribute__((ext_vector_type(4)));
typedef float f32x16 __attribute__((ext_vector_type(16)));
typedef unsigned u32x4 __attribute__((ext_vector_type(4)));
typedef unsigned u32x2 __attribute__((ext_vector_type(2)));
typedef float f32x2_t __attribute__((ext_vector_type(2)));
typedef __bf16 bf16x2_t __attribute__((ext_vector_type(2)));

constexpr int DM = 2048, NTOK = 24576, NTOK_P = 8192, SEQ_P = 4096, SEQ_S = 2048, DFF = 5632, NLAYER = 4;
constexpr float EPS = 1e-6f;
constexpr float LOG2E = 1.4426950408889634f;
constexpr float QSCALE = 0.125f * LOG2E;

constexpr size_t MiB = 1u << 20;
constexpr size_t WS_CTL = 0;
constexpr size_t WS_BAR = 65536;
constexpr size_t WS_CNT = 131072;
constexpr size_t ZERO_OFF = 65536, ZERO_BYTES = 1048576 - 65536;
constexpr size_t WS_X1 = 1 * MiB;
constexpr size_t WS_RSS = 262144, RSS_BYTES = 8 * 24576 * 4;
constexpr size_t WS_WB = 4 * MiB;
constexpr size_t WS_WB1 = 70 * MiB;
constexpr size_t WS_H = 136 * MiB;
constexpr size_t WS_DFTC = 232 * MiB;
constexpr size_t WS_CS4 = 233 * MiB;
constexpr size_t WS_CS2 = 297 * MiB;
constexpr size_t WS_SCR = 313 * MiB;
constexpr size_t WS_END = WS_SCR + 528 * MiB;
constexpr size_t WB_QKF = 0, WB_V = 12 * MiB, WB_OUT = 16 * MiB;
constexpr size_t WB_CX = 0, WB_CB = 16 * MiB, WB_COUT = 24 * MiB;
constexpr size_t WB_G = 0, WB_U = 22 * MiB, WB_D = 44 * MiB;
constexpr size_t SC_GATE = 0, SC_ACT = 264 * MiB, SC_FM = 0;
constexpr size_t SC_ZQKF = 0, SC_VT = 144 * MiB, SC_CAT = 192 * MiB, SC_YT = 288 * MiB, SC_ABM = 384 * MiB;
constexpr size_t SC_P = 0, SC_U = 96 * MiB, SC_CM = 192 * MiB;
constexpr size_t YT_S_OFF = (size_t)4 * 256 * 2 * 2 * SEQ_P * 2;

constexpr int LDS_BYTES = 147456;
constexpr int LDS_BT = 131072;
constexpr int LDS_MISC = 133120;
constexpr int LDS_EPI = 134144;

__device__ __forceinline__ unsigned cvtpk(float lo, float hi) { f32x2_t v = {lo, hi}; bf16x2_t b = __builtin_convertvector(v, bf16x2_t); return __builtin_bit_cast(unsigned, b); }
__device__ __forceinline__ float bflo(unsigned u) { return __uint_as_float(u << 16); }
__device__ __forceinline__ float bfhi(unsigned u) { return __uint_as_float(u & 0xffff0000u); }
__device__ __forceinline__ float wave_sum(float v) {
#pragma unroll
    for (int o = 1; o < 64; o <<= 1) v += __shfl_xor(v, o);
    return v;
}

typedef unsigned rss_t;
constexpr float RSS_FX = 16384.f, RSS_INV = 1.f / (16384.f * 2048.f);
__device__ __forceinline__ float rss_rstd(rss_t v) { return __builtin_amdgcn_rsqf((float)v * RSS_INV + 1e-6f); }
namespace pg8 {
constexpr int BM = 256, BK = 64, HALF = 128, HTB = HALF * BK * 2, NXCD = 8, WGM = 8;
__device__ __forceinline__ int lds_byte(int r, int c) { const int st = (r >> 4) * 2 + (c >> 5), rr = r & 15, cc = c & 31, ob = rr * 64 + cc * 2; return st * 1024 + (ob ^ (((ob >> 9) & 1) << 5)); }
__device__ __forceinline__ void stage_rc(int b, int& R, int& C) { const int st = b / 1024, sb = b % 1024, swz = sb ^ (((sb >> 9) & 1) << 5); R = (st >> 1) * 16 + swz / 64; C = (st & 1) * 32 + (swz % 64) / 2; }
__device__ __forceinline__ int perm32(int rho) { const int n = rho >> 4, i = rho & 15; return 8 * (i >> 2) + 4 * n + (i & 3); }

struct Unit { int pm, pn, z; };

__device__ __forceinline__ void tile_map(int L, int nM, int nN, int& pm, int& pn) {
    const int nwg = nM * nN; int wgid = L;
    { const int q = nwg / NXCD, r = nwg % NXCD, xcd = wgid % NXCD, off = wgid / NXCD; wgid = (xcd < r ? xcd * (q + 1) : r * (q + 1) + (xcd - r) * q) + off; }
    const int nig = WGM * nN, gid = wgid / nig, fm = gid * WGM, gsz = (nM - fm) < WGM ? (nM - fm) : WGM;
    pm = fm + ((wgid % nig) % gsz); pn = (wgid % nig) / gsz;
}

template <class Prob, class Epi>
__device__ __forceinline__ void gemm_phase(LAS unsigned char* lds, const Prob& P, const Epi& E) {
    int tid = threadIdx.x; asm volatile("" : "+v"(tid));
    const int wid = __builtin_amdgcn_readfirstlane(tid >> 6), lane = tid & 63, wr = wid >> 2, wc = wid & 3, fr = lane & 15, fq = lane >> 4;
    const int K = P.K, nt = K / BK, lda = P.lda, ldb = P.ldb;
    unsigned voffA[2], voffB[2];
#pragma unroll
    for (int i = 0; i < 2; ++i) { int R, C; stage_rc(tid * 16 + i * 8192, R, C); const int Rb = (R & ~31) + perm32(R & 31);
        voffA[i] = (unsigned)(R * lda + C) * 2u; voffB[i] = (unsigned)(Rb * ldb + C) * 2u; }
    const size_t kstep = (size_t)(BK * 2);
    const size_t hstepA = (size_t)HALF * lda * 2, hstepB = (size_t)HALF * ldb * 2;
    const unsigned ldsw = (unsigned)wid * 1024u;
    const int aoff = lds_byte(wr * 64 + fr, fq * 8), boff = lds_byte(wc * 32 + fr, fq * 8);
#define PG8_SA(b, h) (((b) * 2 + (h)) * HTB)
#define PG8_SB(b, h) ((4 + (b) * 2 + (h)) * HTB)
#define PG8_STAGE(bufoff, gbase, voff) do { _Pragma("unroll") for (int _i = 0; _i < 2; ++_i) \
        __builtin_amdgcn_global_load_lds((const unsigned*)((const char*)(gbase) + (voff)[_i]), (LAS unsigned*)(lds + (bufoff) + ldsw + _i * 8192), 16, 0, 0); } while (0)
#define PG8_LDA(dst, b, h) do { _Pragma("unroll") for (int m = 0; m < 4; ++m) _Pragma("unroll") for (int k = 0; k < 2; ++k) dst[m][k] = *(const LAS bf16x8*)(lds + PG8_SA(b, h) + aoff + m * 2048 + k * 1024); } while (0)
#define PG8_LDB(dst, b, h) do { _Pragma("unroll") for (int n = 0; n < 2; ++n) _Pragma("unroll") for (int k = 0; k < 2; ++k) dst[n][k] = *(const LAS bf16x8*)(lds + PG8_SB(b, h) + boff + n * 2048 + k * 1024); } while (0)
#define PG8_MMA(ai, bj, At, Bt) do { __builtin_amdgcn_s_setprio(1); _Pragma("unroll") for (int m = 0; m < 4; ++m) _Pragma("unroll") for (int n = 0; n < 2; ++n) _Pragma("unroll") for (int k = 0; k < 2; ++k) \
        acc[ai][bj][m][n] = __builtin_amdgcn_mfma_f32_16x16x32_bf16(Bt[n][k], At[m][k], acc[ai][bj][m][n], 0, 0, 0); __builtin_amdgcn_s_setprio(0); } while (0)
#define PG8_WAIT_V(n) asm volatile("s_waitcnt vmcnt(" #n ")" ::: "memory")
#define PG8_WAIT_L(n) asm volatile("s_waitcnt lgkmcnt(" #n ")" ::: "memory")
#define PG8_BAR __builtin_amdgcn_s_barrier()
#define PG8_SCHED __builtin_amdgcn_sched_barrier(0)
    Unit cur, nxt; int ui = 0;
    if (!P.next(0, cur)) return;
    f32x4 acc[2][2][4][2];
#pragma unroll
    for (int a = 0; a < 2; ++a)
#pragma unroll
        for (int b = 0; b < 2; ++b)
#pragma unroll
            for (int m = 0; m < 4; ++m)
#pragma unroll
                for (int n = 0; n < 2; ++n) acc[a][b][m][n] = (f32x4){0.f, 0.f, 0.f, 0.f};
    bf16x8 At[4][2], B0[2][2], B1[2][2];
    const char* cA = P.a_ptr(cur); const char* cB = P.b_ptr(cur);
    PG8_STAGE(PG8_SB(0, 0), cB, voffB); PG8_STAGE(PG8_SB(0, 1), cB + hstepB, voffB); PG8_STAGE(PG8_SA(0, 0), cA, voffA); PG8_STAGE(PG8_SA(0, 1), cA + hstepA, voffA);
    if (wr == 1) PG8_BAR;
    PG8_WAIT_V(2); PG8_BAR;
    PG8_STAGE(PG8_SB(1, 0), cB + kstep, voffB); PG8_STAGE(PG8_SA(1, 0), cA + kstep, voffA); PG8_STAGE(PG8_SB(1, 1), cB + hstepB + kstep, voffB);
    PG8_WAIT_V(6); PG8_BAR;
    for (;;) {
        const bool has_next = P.next(ui + 1, nxt);
        const char* nA = has_next ? P.a_ptr(nxt) : cA; const char* nB = has_next ? P.b_ptr(nxt) : cB;
        for (int t = 0; t < nt; t += 2) {
            const bool last = (t == nt - 2);
            const char* a1 = cA + (size_t)(t + 1) * kstep;
            const char* a2 = last ? nA : cA + (size_t)(t + 2) * kstep; const char* b2 = last ? nB : cB + (size_t)(t + 2) * kstep;
            const char* a3 = a2 + kstep; const char* b3 = b2 + kstep;
            PG8_LDB(B0, 0, 0); PG8_LDB(B1, 0, 1); PG8_SCHED; PG8_LDA(At, 0, 0); PG8_STAGE(PG8_SA(1, 1), a1 + hstepA, voffA);
            PG8_WAIT_V(8); PG8_WAIT_L(0); PG8_BAR; PG8_MMA(0, 0, At, B0); PG8_MMA(0, 1, At, B1); PG8_BAR; PG8_SCHED;
            PG8_LDA(At, 0, 1); PG8_STAGE(PG8_SB(0, 0), b2, voffB); PG8_STAGE(PG8_SB(0, 1), b2 + hstepB, voffB); PG8_STAGE(PG8_SA(0, 0), a2, voffA);
            PG8_WAIT_V(8); PG8_WAIT_L(0); PG8_BAR; PG8_MMA(1, 0, At, B0); PG8_MMA(1, 1, At, B1); PG8_BAR; PG8_SCHED;
            PG8_LDB(B0, 1, 0); PG8_LDB(B1, 1, 1); PG8_SCHED; PG8_LDA(At, 1, 0); PG8_STAGE(PG8_SA(0, 1), a2 + hstepA, voffA);
            PG8_WAIT_V(8); PG8_WAIT_L(0); PG8_BAR; PG8_MMA(0, 0, At, B0); PG8_MMA(0, 1, At, B1); PG8_BAR; PG8_SCHED;
            PG8_LDA(At, 1, 1); PG8_STAGE(PG8_SB(1, 0), b3, voffB); PG8_STAGE(PG8_SB(1, 1), b3 + hstepB, voffB); PG8_STAGE(PG8_SA(1, 0), a3, voffA);
            PG8_WAIT_V(8); PG8_WAIT_L(0); PG8_BAR; PG8_MMA(1, 0, At, B0); PG8_MMA(1, 1, At, B1); PG8_BAR; PG8_SCHED;
        }
        if (wr == 0) PG8_BAR;
        E(acc, cur, wr, wc, fr, fq);
        if (!has_next) break;
#pragma unroll
        for (int a = 0; a < 2; ++a)
#pragma unroll
            for (int b = 0; b < 2; ++b)
#pragma unroll
                for (int m = 0; m < 4; ++m)
#pragma unroll
                    for (int n = 0; n < 2; ++n) acc[a][b][m][n] = (f32x4){0.f, 0.f, 0.f, 0.f};
        cur = nxt; cA = nA; cB = nB; ++ui;
        if (wr == 1) PG8_BAR;
    }
    PG8_WAIT_V(0);
    PG8_BAR;
#undef PG8_SA
#undef PG8_SB
#undef PG8_STAGE
#undef PG8_LDA
#undef PG8_LDB
#undef PG8_MMA
#undef PG8_WAIT_V
#undef PG8_WAIT_L
#undef PG8_BAR
#undef PG8_SCHED
}

struct ProbSimple {
    const char* A; const char* B; int K, lda, ldb, nM, nN, G, c;
    __device__ __forceinline__ bool next(int i, Unit& u) const { const int L = i * G + c; if (L >= nM * nN) return false; tile_map(L, nM, nN, u.pm, u.pn); u.z = 0; return true; }
    __device__ __forceinline__ const char* a_ptr(const Unit& u) const { return A + (size_t)u.pm * 256 * lda * 2; }
    __device__ __forceinline__ const char* b_ptr(const Unit& u) const { return B + (size_t)u.pn * 256 * ldb * 2; }
};
struct ProbAB1 {
    const char* H; const char* Wqkf; const char* Wv; int K, lda, ldb, G, c;
    __device__ __forceinline__ bool next(int i, Unit& u) const {
        const int L = i * G + c; if (L >= 1536) return false;
        if (L < 1152) { tile_map(L, 96, 12, u.pm, u.pn); u.z = 0; } else { tile_map(L - 1152, 4, 96, u.pm, u.pn); u.z = 1; }
        return true; }
    __device__ __forceinline__ const char* a_ptr(const Unit& u) const { return (u.z ? Wv : H) + (size_t)u.pm * 256 * 2048 * 2; }
    __device__ __forceinline__ const char* b_ptr(const Unit& u) const { return (u.z ? H : Wqkf) + (size_t)u.pn * 256 * 2048 * 2; }
};
struct ProbF1 {
    const char* Cm; const char* F; int K, lda, ldb, G, c;
    __device__ __forceinline__ bool next(int i, Unit& u) const { const int L = i * G + c; if (L >= 768) return false; u.z = L / 192; tile_map(L % 192, 2, 96, u.pm, u.pn); return true; }
    __device__ __forceinline__ const char* a_ptr(const Unit& u) const { return Cm + (size_t)u.pm * 256 * 256 * 2; }
    __device__ __forceinline__ const char* b_ptr(const Unit& u) const { return F + (size_t)u.z * 256 * 2 + (size_t)u.pn * 256 * 3072 * 2; }
};
struct ProbF2 {
    const char* CS; const char* Y; int K, lda, ldb, nB, nPm, first, count;
    __device__ __forceinline__ bool next(int i, Unit& u) const { if (i >= count) return false; const int L = first + i; u.z = L / nPm; u.pm = L % nPm; u.pn = 0; return true; }
    __device__ __forceinline__ const char* a_ptr(const Unit& u) const { return CS + (size_t)u.pm * 256 * lda * 2; }
    __device__ __forceinline__ const char* b_ptr(const Unit& u) const { const int b = u.z >> 2, g = u.z & 3; return Y + ((size_t)(g * 256) * nB + b) * (size_t)K * 2; }
};

template <class Addr> struct EpiStore {
    Addr ad;
    __device__ __forceinline__ void operator()(const f32x4 (&acc)[2][2][4][2], const Unit& u, int wr, int wc, int fr, int fq) const {
        bf16_t* base; int ldc; float sc; const rss_t* rs; int rsm; ad.get(u, base, ldc, sc, rs, rsm);
        bf16_t* p0 = base + (size_t)(wr * 64 + fr) * ldc + wc * 32 + 8 * fq;
        f32x4 cs[2][2];
#pragma unroll
        for (int bj = 0; bj < 2; ++bj)
#pragma unroll
            for (int n = 0; n < 2; ++n) { cs[bj][n] = (f32x4){sc, sc, sc, sc};
                if (rsm == 2) { const rss_t* q = rs + bj * HALF + wc * 32 + 8 * fq + 4 * n;
#pragma unroll
                    for (int e = 0; e < 4; ++e) cs[bj][n][e] = sc * rss_rstd(q[e]); } }
#pragma unroll
        for (int ai = 0; ai < 2; ++ai)
#pragma unroll
            for (int m = 0; m < 4; ++m) { bf16_t* rowp = p0 + (size_t)(ai * HALF + m * 16) * ldc;
                float rsc = 1.f; if (rsm == 1) rsc = rss_rstd(rs[ai * HALF + wr * 64 + m * 16 + fr]);
#pragma unroll
                for (int bj = 0; bj < 2; ++bj) { const f32x4 v0 = acc[ai][bj][m][0] * cs[bj][0] * rsc, v1 = acc[ai][bj][m][1] * cs[bj][1] * rsc;
                    u32x4 w; w.x = cvtpk(v0[0], v0[1]); w.y = cvtpk(v0[2], v0[3]); w.z = cvtpk(v1[0], v1[1]); w.w = cvtpk(v1[2], v1[3]);
                    *(u32x4*)(rowp + bj * HALF) = w; } }
    }
};
struct AddrPlain { bf16_t* out; int ldc; const rss_t* rss;
    __device__ __forceinline__ void get(const Unit& u, bf16_t*& base, int& l, float& sc, const rss_t*& rs, int& rsm) const { base = out + (size_t)u.pm * 256 * ldc + u.pn * 256; l = ldc; sc = 1.f;
        rs = rss + u.pm * 256; rsm = rss ? 1 : 0; } };
struct AddrAB1 { bf16_t* zqkf; bf16_t* vt; const rss_t* rss;
    __device__ __forceinline__ void get(const Unit& u, bf16_t*& base, int& l, float& sc, const rss_t*& rs, int& rsm) const {
        if (u.z == 0) { base = zqkf + (size_t)u.pm * 256 * 3072 + u.pn * 256; l = 3072; sc = (u.pn < 4) ? QSCALE : 1.f; rs = rss + u.pm * 256; rsm = 1; }
        else { base = vt + (size_t)u.pm * 256 * NTOK + u.pn * 256; l = NTOK; sc = 1.f; rs = rss + u.pn * 256; rsm = 2; } } };
struct AddrF1 { bf16_t* yt;
    __device__ __forceinline__ void get(const Unit& u, bf16_t*& base, int& l, float& sc, const rss_t*& rs, int& rsm) const {
        sc = 1.f; rs = nullptr; rsm = 0; const int g = u.z;
        if (u.pn < 32) { const int b = u.pn >> 4, s0 = (u.pn & 15) * 256; base = yt + ((size_t)(g * 256) * 2 + b) * 8192 + (size_t)u.pm * 4096 + s0; l = 2 * 8192; }
        else { const int t = u.pn * 256 - NTOK_P, b = t >> 11, s0 = t & 2047; base = yt + YT_S_OFF / 2 + ((size_t)(g * 256) * 8 + b) * 4096 + (size_t)u.pm * 2048 + s0; l = 8 * 4096; } } };
struct AddrF2 { bf16_t* cat; int tok0, S;
    __device__ __forceinline__ void get(const Unit& u, bf16_t*& base, int& l, float& sc, const rss_t*& rs, int& rsm) const {
        rs = nullptr; rsm = 0; const int b = u.z >> 2, g = u.z & 3; base = cat + (size_t)(tok0 + b * S + u.pm * 256) * DM + 1024 + g * 256; l = DM; sc = 1.f; } };

struct ProbF1G {
    const char* Hh; const char* Wg; const char* Wu; int K, lda, ldb, G, c;
    __device__ __forceinline__ bool next(int i, Unit& u) const {
        const int L = i * G + c; if (L >= 2304) return false;
        if (L < 2112) { tile_map(L, 96, 22, u.pm, u.pn); u.z = 0; } else { tile_map(L - 2112, 96, 2, u.pm, u.pn); u.z = 1; }
        return true; }
    __device__ __forceinline__ const char* a_ptr(const Unit& u) const { return Hh + (size_t)u.pm * 256 * 2048 * 2; }
    __device__ __forceinline__ const char* b_ptr(const Unit& u) const { return (u.z ? Wu + (size_t)20 * 256 * 2048 * 2 : Wg) + (size_t)u.pn * 256 * 2048 * 2; }
};
struct AddrF1G { bf16_t* gate; bf16_t* upraw; const rss_t* rss;
    __device__ __forceinline__ void get(const Unit& u, bf16_t*& base, int& l, float& sc, const rss_t*& rs, int& rsm) const { sc = 1.f; rs = rss + u.pm * 256;
        if (u.z == 0) { base = gate + (size_t)u.pm * 256 * DFF + u.pn * 256; l = DFF; rsm = 1; } else { base = upraw + (size_t)u.pm * 256 * 512 + u.pn * 256; l = 512; rsm = 0; } } };
struct EpiMulHalves {
    bf16_t* out; int ldc; const rss_t* rss;
    __device__ __forceinline__ void operator()(const f32x4 (&acc)[2][2][4][2], const Unit& u, int wr, int wc, int fr, int fq) const {
        bf16_t* p0 = out + (size_t)(u.pm * 256 + wr * 64 + fr) * ldc + u.pn * 128 + wc * 32 + 8 * fq;
#pragma unroll
        for (int ai = 0; ai < 2; ++ai)
#pragma unroll
            for (int m = 0; m < 4; ++m) { const float r2 = 1.f / ((float)rss[u.pm * 256 + ai * HALF + wr * 64 + m * 16 + fr] * RSS_INV + 1e-6f);
                const f32x4 v0 = acc[ai][0][m][0] * acc[ai][1][m][0] * r2, v1 = acc[ai][0][m][1] * acc[ai][1][m][1] * r2;
                u32x4 w; w.x = cvtpk(v0[0], v0[1]); w.y = cvtpk(v0[2], v0[3]); w.z = cvtpk(v1[0], v1[1]); w.w = cvtpk(v1[2], v1[3]);
                *(u32x4*)(p0 + (size_t)(ai * HALF + m * 16) * ldc) = w; }
    }
};
template <bool SILU> struct EpiConvMul {
    const bf16_t* src; bf16_t* out; const float* cw; const float* cb; int ld;
    __device__ __forceinline__ void operator()(const f32x4 (&acc)[2][2][4][2], const Unit& u, int wr, int wc, int fr, int fq) const {
        const int lane = threadIdx.x & 63; const int laneR = (lane & 48) | ((lane - 1) & 15), laneL = (lane & 48) | ((lane + 1) & 15);
#pragma unroll
        for (int bj = 0; bj < 2; ++bj) {
            const int c0 = u.pn * 256 + bj * HALF + wc * 32 + 8 * fq;
            float w0[8], w1[8], w2[8], bb[8];
#pragma unroll
            for (int h = 0; h < 2; ++h) { const f32x4 a = *(const f32x4*)(cw + c0 + 4 * h), b = *(const f32x4*)(cw + ld + c0 + 4 * h), c = *(const f32x4*)(cw + 2 * ld + c0 + 4 * h);
                f32x4 d = (f32x4){0.f, 0.f, 0.f, 0.f}; if (SILU) d = *(const f32x4*)(cb + c0 + 4 * h);
#pragma unroll
                for (int e = 0; e < 4; ++e) { w0[4 * h + e] = a[e]; w1[4 * h + e] = b[e]; w2[4 * h + e] = c[e]; bb[4 * h + e] = d[e]; } }
#pragma unroll
            for (int ai = 0; ai < 2; ++ai) {
                u32x4 cur[4], et, eb;
                {
                    const int row0 = u.pm * 256 + ai * HALF + wr * 64;
                    const int smask = row0 < NTOK_P ? (SEQ_P - 1) : (SEQ_S - 1);
                    const bool hp = (row0 & smask) != 0, hn = ((row0 + 63) & smask) != smask;
                    const bf16_t* sp = src + (size_t)(row0 + fr) * ld + c0;
#pragma unroll
                    for (int m = 0; m < 4; ++m) cur[m] = *(const u32x4*)(sp + (size_t)(m * 16) * ld);
                    const bf16_t* s0 = src + (size_t)row0 * ld + c0;
                    et = *(const u32x4*)(hp ? s0 - ld : s0); eb = *(const u32x4*)(hn ? s0 + (size_t)64 * ld : s0);
                    if (!hp) et = (u32x4){0u, 0u, 0u, 0u}; if (!hn) eb = (u32x4){0u, 0u, 0u, 0u};
                }
                asm volatile("" ::: "memory");
                u32x4 Rp = et;
#pragma unroll
                for (int m = 0; m < 4; ++m) {
                    const int row = u.pm * 256 + ai * HALF + wr * 64 + m * 16 + fr;
                    const u32x4 cu = cur[m];
                    u32x4 R, L, Ln;
#pragma unroll
                    for (int e = 0; e < 4; ++e) { R[e] = (unsigned)__shfl((int)cu[e], laneR); L[e] = (unsigned)__shfl((int)cu[e], laneL); }
                    if (m < 3) {
#pragma unroll
                        for (int e = 0; e < 4; ++e) Ln[e] = (unsigned)__shfl((int)cur[m < 3 ? m + 1 : 3][e], laneL);
                    } else Ln = eb;
                    u32x4 pv, nx;
#pragma unroll
                    for (int e = 0; e < 4; ++e) { pv[e] = fr == 0 ? Rp[e] : R[e]; nx[e] = fr == 15 ? Ln[e] : L[e]; }
                    Rp = R;
                    float r[8];
#pragma unroll
                    for (int e = 0; e < 4; ++e) {
                        float g0 = w0[2 * e] * bflo(pv[e]) + w1[2 * e] * bflo(cu[e]) + w2[2 * e] * bflo(nx[e]) + bb[2 * e];
                        float g1 = w0[2 * e + 1] * bfhi(pv[e]) + w1[2 * e + 1] * bfhi(cu[e]) + w2[2 * e + 1] * bfhi(nx[e]) + bb[2 * e + 1];
                        if (SILU) { g0 = g0 * __builtin_amdgcn_rcpf(1.f + __builtin_amdgcn_exp2f(-g0 * LOG2E)); g1 = g1 * __builtin_amdgcn_rcpf(1.f + __builtin_amdgcn_exp2f(-g1 * LOG2E)); }
                        r[2 * e] = g0 * acc[ai][bj][m][e >> 1][(2 * e) & 3]; r[2 * e + 1] = g1 * acc[ai][bj][m][e >> 1][(2 * e + 1) & 3]; }
                    u32x4 w; w.x = cvtpk(r[0], r[1]); w.y = cvtpk(r[2], r[3]); w.z = cvtpk(r[4], r[5]); w.w = cvtpk(r[6], r[7]);
                    *(u32x4*)(out + (size_t)row * ld + c0) = w; }
                asm volatile("" ::: "memory");
            }
            asm volatile("" ::: "memory");
        }
    }
};
struct ProbPanel {
    const char* A; const char* B; int K, lda, ldb, bx;
    __device__ __forceinline__ bool next(int i, Unit& u) const { if (i >= 3) return false; const int slot = bx >> 3; u.pm = i * 32 + (bx & 7) * 4 + (slot >> 3); u.pn = slot & 7; u.z = 0; return true; }
    __device__ __forceinline__ const char* a_ptr(const Unit& u) const { return A + (size_t)u.pm * 256 * lda * 2; }
    __device__ __forceinline__ const char* b_ptr(const Unit& u) const { return B + (size_t)u.pn * 256 * ldb * 2; }
};
__device__ __forceinline__ void panel_rstd(const f32x4 (&v)[2][2][4][2], int pm, int pn, int wr, int wc, int fr, int fq, float* X, unsigned* cnt, unsigned* tmo, LAS unsigned char* l2, int tid, const rss_t* rin) {
    LAS float* Pp = (LAS float*)l2; LAS float* S = (LAS float*)(l2 + 4096);
    const int wid = __builtin_amdgcn_readfirstlane(tid >> 6), lane = tid & 63;
#pragma unroll
    for (int ai = 0; ai < 2; ++ai)
#pragma unroll
        for (int m = 0; m < 4; ++m) { float s = 0.f;
#pragma unroll
            for (int bj = 0; bj < 2; ++bj)
#pragma unroll
                for (int n = 0; n < 2; ++n) { const f32x4 x = v[ai][bj][m][n]; s += (x[0] * x[0] + x[1] * x[1]) + (x[2] * x[2] + x[3] * x[3]); }
            s += __shfl_xor(s, 16); s += __shfl_xor(s, 32);
            if (fq == 0) Pp[(ai * HALF + wr * 64 + m * 16 + fr) * 4 + wc] = s; }
    asm volatile("s_waitcnt lgkmcnt(0)" ::: "memory"); __builtin_amdgcn_s_barrier(); asm volatile("" ::: "memory");
    if (tid < 256) { const float t = (Pp[tid * 4] + Pp[tid * 4 + 1]) + (Pp[tid * 4 + 2] + Pp[tid * 4 + 3]);
        __hip_atomic_store((unsigned*)X + ((size_t)(pm * 256 + tid) * 8 + pn), __float_as_uint(t), __ATOMIC_RELAXED, __HIP_MEMORY_SCOPE_AGENT); }
    asm volatile("s_waitcnt vmcnt(0)" ::: "memory");
    if (tid < 256 && lane == 0) __hip_atomic_fetch_add(cnt, 1u, __ATOMIC_RELAXED, __HIP_MEMORY_SCOPE_AGENT);
    if (wid == 0) {
        unsigned sp = 0;
        for (;;) {
            if ((unsigned)__builtin_amdgcn_readfirstlane(__hip_atomic_load(cnt, __ATOMIC_RELAXED, __HIP_MEMORY_SCOPE_AGENT)) >= 32u) break;
            __builtin_amdgcn_s_sleep(1);
            if ((++sp & 255u) == 0u) { if (__hip_atomic_load(tmo, __ATOMIC_RELAXED, __HIP_MEMORY_SCOPE_AGENT)) break; if (sp > (1u << 22)) { if (lane == 0) atomicAdd(tmo, 1u); break; } }
        }
        __builtin_amdgcn_fence(__ATOMIC_ACQUIRE, "agent");
    }
    asm volatile("s_waitcnt vmcnt(0) lgkmcnt(0)" ::: "memory"); __builtin_amdgcn_s_barrier(); asm volatile("" ::: "memory");
    if (tid < 256) { const unsigned long long* sl = (const unsigned long long*)((const unsigned*)X + (size_t)(pm * 256 + tid) * 8); float ss = 0.f;
#pragma unroll
        for (int t = 0; t < 4; ++t) { const unsigned long long w = __hip_atomic_load(sl + t, __ATOMIC_RELAXED, __HIP_MEMORY_SCOPE_AGENT); ss += __uint_as_float((unsigned)w) + __uint_as_float((unsigned)(w >> 32)); }
        float rs = 1.f; if (rin) rs = rss_rstd(rin[pm * 256 + tid]);
        S[tid] = rs * __builtin_amdgcn_rsqf(rs * rs * ss * (1.f / 2048.f) + 1e-6f); }
    asm volatile("s_waitcnt lgkmcnt(0)" ::: "memory"); __builtin_amdgcn_s_barrier(); asm volatile("" ::: "memory");
}
struct EpiNormRes {
    bf16_t* xb; float* fout; const float* gpost; rss_t* rss_out; const rss_t* rss_in; float* X1; unsigned* cnt1; unsigned* tmo; LAS unsigned char* l2;
    __device__ __forceinline__ void operator()(f32x4 (&acc)[2][2][4][2], const Unit& u, int wr, int wc, int fr, int fq) const {
        int tid = threadIdx.x; asm volatile("" : "+v"(tid));
        const LAS float* S = (const LAS float*)(l2 + 4096);
        const int col0 = u.pn * 256 + wc * 32 + 8 * fq;
        const size_t toff = (size_t)(u.pm * 256 + wr * 64 + fr) * DM + col0;
        bf16_t* xt = xb + toff;
        u32x4 pre[4][2];
#define NR_LOAD(ai) do { _Pragma("unroll") for (int m = 0; m < 4; ++m) _Pragma("unroll") for (int bj = 0; bj < 2; ++bj) \
            pre[m][bj] = *(const u32x4*)(xt + (size_t)((ai) * HALF + m * 16) * DM + bj * HALF); asm volatile("" ::: "memory"); } while (0)
#define NR_APPLY(ai) do { _Pragma("unroll") for (int m = 0; m < 4; ++m) { const int rl_ = (ai) * HALF + wr * 64 + m * 16 + fr; const float r1 = S[rl_]; float q_ = 0.f; \
            _Pragma("unroll") for (int bj = 0; bj < 2; ++bj) { const u32x4 pv_ = pre[m][bj]; f32x4 xn0_, xn1_; \
                xn0_[0] = bflo(pv_[0]); xn0_[1] = bfhi(pv_[0]); xn0_[2] = bflo(pv_[1]); xn0_[3] = bfhi(pv_[1]); xn1_[0] = bflo(pv_[2]); xn1_[1] = bfhi(pv_[2]); xn1_[2] = bflo(pv_[3]); xn1_[3] = bfhi(pv_[3]); \
                xn0_ = xn0_ + acc[ai][bj][m][0] * r1 * g[bj][0]; xn1_ = xn1_ + acc[ai][bj][m][1] * r1 * g[bj][1]; \
                if (fout) { float* fo_ = fout + toff + (size_t)((ai) * HALF + m * 16) * DM + bj * HALF; *(f32x4*)fo_ = xn0_; *(f32x4*)(fo_ + 4) = xn1_; } \
                else { u32x4 w_; w_.x = cvtpk(xn0_[0], xn0_[1]); w_.y = cvtpk(xn0_[2], xn0_[3]); w_.z = cvtpk(xn1_[0], xn1_[1]); w_.w = cvtpk(xn1_[2], xn1_[3]); \
                    *(u32x4*)(xt + (size_t)((ai) * HALF + m * 16) * DM + bj * HALF) = w_; \
                      \
                    const float a0_ = bflo(w_.x), a1_ = bfhi(w_.x), a2_ = bflo(w_.y), a3_ = bfhi(w_.y), a4_ = bflo(w_.z), a5_ = bfhi(w_.z), a6_ = bflo(w_.w), a7_ = bfhi(w_.w); \
                    q_ += ((a0_ * a0_ + a1_ * a1_) + (a2_ * a2_ + a3_ * a3_)) + ((a4_ * a4_ + a5_ * a5_) + (a6_ * a6_ + a7_ * a7_)); } } \
            if (!fout) { q_ += __shfl_xor(q_, 16); q_ += __shfl_xor(q_, 32); if (fq == 0) atomicAdd(rss_out + u.pm * 256 + rl_, (rss_t)(q_ * RSS_FX + 0.5f)); } } asm volatile("" ::: "memory"); } while (0)
        NR_LOAD(0);
        panel_rstd(acc, u.pm, u.pn, wr, wc, fr, fq, X1, cnt1 + u.pm * 16, tmo, l2, tid, rss_in);
        {
            f32x4 g[2][2];
#pragma unroll
            for (int bj = 0; bj < 2; ++bj) { g[bj][0] = *(const f32x4*)(gpost + col0 + bj * HALF); g[bj][1] = *(const f32x4*)(gpost + col0 + bj * HALF + 4); }
            NR_APPLY(0);
            NR_LOAD(1); NR_APPLY(1);
        }
#undef NR_LOAD
#undef NR_APPLY
    }
};
}

constexpr int AT_STAGE = 36864, AT_K1 = 9216, AT_V = 18432, AT_PITCH = 144;
__device__ __forceinline__ void attn_unit(LAS unsigned char* lds, const bf16_t* __restrict__ zqkf, const bf16_t* __restrict__ Vt, bf16_t* cat,
                                          const float* __restrict__ biasT, const float* __restrict__ subln, float lam, float oscale, int tokbase, int S, int h, int q0) {
    int tid = threadIdx.x; asm volatile("" : "+v"(tid));
    const int lane = tid & 63, w = __builtin_amdgcn_readfirstlane(tid >> 6), g = w & 3, mp = w >> 2, r32 = lane & 31, hi = lane >> 5;
    LAS float* bt = (LAS float*)(lds + LDS_BT);
    if (tid < 257) bt[tid] = biasT[h * 260 + tid];
    const float cL = biasT[h * 260], cR = biasT[h * 260 + 256];
    bf16x8 qr[4];
    { const bf16_t* qp = zqkf + (size_t)(tokbase + q0 + 32 * g + r32) * 3072 + h * 128 + mp * 64 + 8 * hi;
#pragma unroll
      for (int d0 = 0; d0 < 4; ++d0) qr[d0] = *(const bf16x8*)(qp + 16 * d0); }
    const int NT = S >> 6;
    unsigned voff[5];
#pragma unroll
    for (int k = 0; k < 5; ++k) { const int q = w + 8 * k; const int sp = q < 9 ? q : (q < 18 ? q - 9 : q - 18); const int ci = sp * 64 + lane; const int row = ci / 9; int ch = ci - row * 9; ch = ch > 7 ? 7 : ch;
        voff[k] = q < 18 ? (unsigned)(row * 3072 + ch * 8) * 2u : (q < 36 ? (unsigned)(row * NTOK + ch * 8) * 2u : 0u); }
    const char* kg0 = (const char*)(zqkf + (size_t)tokbase * 3072 + 1024 + h * 128);
    const char* vg0 = (const char*)(Vt + (size_t)(h * 128) * NTOK + tokbase);
#define AT_DMA(t, stg) do { const char* kb0_ = kg0 + (size_t)(t) * (64 * 3072 * 2); const char* vb0_ = vg0 + (size_t)(t) * 128; \
        _Pragma("unroll") for (int k = 0; k < 5; ++k) { const int q = w + 8 * k; const char* b_ = q < 9 ? kb0_ : (q < 18 ? kb0_ + 128 : (q < 36 ? vb0_ : kb0_)); \
            const int d_ = q < 36 ? (stg) * AT_STAGE + q * 1024 : 3 * AT_STAGE + (q - 36) * 1024; \
            __builtin_amdgcn_global_load_lds((const unsigned*)(b_ + voff[k]), (LAS unsigned*)(lds + d_), 16, 0, 0); } } while (0)
    AT_DMA(0, 0); if (1 < NT) AT_DMA(1, 1);
    asm volatile("s_waitcnt vmcnt(0)" ::: "memory");
    __syncthreads();
    float m_run = -INFINITY, l_run = 0.f;
    f32x16 o[4];
#pragma unroll
    for (int d = 0; d < 4; ++d)
#pragma unroll
        for (int r = 0; r < 16; ++r) o[d][r] = 0.f;
    const int kap = 16 * ((r32 >> 2) & 1) + (r32 & 3) + 4 * (r32 >> 3);
    const int qw0 = q0 + 32 * g, qpos = qw0 + r32;
    f32x16 p1; bf16x8 pw0, pw1;
    f32x16 negm; float cfold = 1e30f;
    m_run = 0.f;
#pragma unroll
    for (int r = 0; r < 16; ++r) negm[r] = 0.f;
#pragma unroll
    for (int r = 0; r < 16; ++r) p1[r] = 0.f;
    pw0 = (bf16x8){0, 0, 0, 0, 0, 0, 0, 0}; pw1 = pw0;
#define AT_BARV5() asm volatile("s_waitcnt vmcnt(5) lgkmcnt(0)\n\ts_barrier" ::: "memory")
#define AT_BARV0() asm volatile("s_waitcnt vmcnt(0) lgkmcnt(0)\n\ts_barrier" ::: "memory")
#define AT_BAR() asm volatile("s_waitcnt lgkmcnt(0)\n\ts_barrier" ::: "memory")
#define AT_X(t, STAGE_OP) do { \
        LAS const unsigned char* st_ = lds + so; LAS const unsigned char* kb_ = st_ + mp * AT_K1 + kap * AT_PITCH + hi * 16; \
        bf16x8 ka_[4], kc_[4]; \
        ka_[0] = *(const LAS bf16x8*)(kb_); ka_[1] = *(const LAS bf16x8*)(kb_ + 32 * AT_PITCH); ka_[2] = *(const LAS bf16x8*)(kb_ + 32); ka_[3] = *(const LAS bf16x8*)(kb_ + 32 * AT_PITCH + 32); \
        __builtin_amdgcn_sched_barrier(0); \
        STAGE_OP; \
        kc_[0] = *(const LAS bf16x8*)(kb_ + 64); kc_[1] = *(const LAS bf16x8*)(kb_ + 32 * AT_PITCH + 64); kc_[2] = *(const LAS bf16x8*)(kb_ + 96); kc_[3] = *(const LAS bf16x8*)(kb_ + 32 * AT_PITCH + 96); \
        __builtin_amdgcn_sched_barrier(0); \
        const int k0_ = (t) * 64; const bool farl_ = k0_ + 63 - qw0 <= -128, farr_ = k0_ - (qw0 + 31) >= 128; \
        const float c_ = farl_ ? cL : (farr_ ? cR : 0.f); \
        if (c_ != cfold) { cfold = c_; _Pragma("unroll") for (int r = 0; r < 16; ++r) negm[r] = c_ - m_run; } \
        f32x16 p0_; \
        __builtin_amdgcn_s_setprio(1); \
        p0_ = __builtin_amdgcn_mfma_f32_32x32x16_bf16(ka_[0], qr[0], negm, 0, 0, 0); p1 = __builtin_amdgcn_mfma_f32_32x32x16_bf16(ka_[1], qr[0], negm, 0, 0, 0); \
        p0_ = __builtin_amdgcn_mfma_f32_32x32x16_bf16(ka_[2], qr[1], p0_, 0, 0, 0); p1 = __builtin_amdgcn_mfma_f32_32x32x16_bf16(ka_[3], qr[1], p1, 0, 0, 0); \
        p0_ = __builtin_amdgcn_mfma_f32_32x32x16_bf16(kc_[0], qr[2], p0_, 0, 0, 0); p1 = __builtin_amdgcn_mfma_f32_32x32x16_bf16(kc_[1], qr[2], p1, 0, 0, 0); \
        p0_ = __builtin_amdgcn_mfma_f32_32x32x16_bf16(kc_[2], qr[3], p0_, 0, 0, 0); p1 = __builtin_amdgcn_mfma_f32_32x32x16_bf16(kc_[3], qr[3], p1, 0, 0, 0); \
        __builtin_amdgcn_s_setprio(0); \
        if (!farl_ && !farr_) { const int rb_ = k0_ + 16 * hi - qpos + 128; \
            _Pragma("unroll") for (int r = 0; r < 16; ++r) { const int i0 = min(max(rb_ + r, 0), 256), i1 = min(max(rb_ + 32 + r, 0), 256); \
                p0_[r] += bt[i0]; p1[r] += bt[i1]; } } \
        float tm_ = fmaxf(p0_[0], p1[0]); \
        _Pragma("unroll") for (int r = 1; r < 16; ++r) tm_ = fmaxf(tm_, fmaxf(p0_[r], p1[r])); \
        { auto rr_ = __builtin_amdgcn_permlane32_swap(__float_as_uint(tm_), __float_as_uint(tm_), false, false);     \
          tm_ = fmaxf(__uint_as_float(rr_[0]), __uint_as_float(rr_[1])); }                   \
          \
          \
        if ((t) == 0 || __any(tm_ > 8.f)) { const float dl_ = (t) == 0 ? tm_ : fmaxf(tm_, 0.f); const float al_ = (t) == 0 ? 0.f : __builtin_amdgcn_exp2f(-dl_); m_run += dl_; l_run *= al_; \
            _Pragma("unroll") for (int r = 0; r < 16; ++r) { p0_[r] -= dl_; p1[r] -= dl_; negm[r] = c_ - m_run; } \
            _Pragma("unroll") for (int d = 0; d < 4; ++d) _Pragma("unroll") for (int r = 0; r < 16; ++r) o[d][r] *= al_; } \
        float ls_ = 0.f; \
        _Pragma("unroll") for (int r = 0; r < 16; ++r) { p0_[r] = __builtin_amdgcn_exp2f(p0_[r]); ls_ += p0_[r]; } \
        l_run += ls_; \
        u32x4 a_, b_; \
        a_.x = cvtpk(p0_[0], p0_[1]); a_.y = cvtpk(p0_[2], p0_[3]); a_.z = cvtpk(p0_[4], p0_[5]); a_.w = cvtpk(p0_[6], p0_[7]); \
        b_.x = cvtpk(p0_[8], p0_[9]); b_.y = cvtpk(p0_[10], p0_[11]); b_.z = cvtpk(p0_[12], p0_[13]); b_.w = cvtpk(p0_[14], p0_[15]); \
        pw0 = __builtin_bit_cast(bf16x8, a_); pw1 = __builtin_bit_cast(bf16x8, b_); } while (0)
#define AT_VRD(dst, db) do { LAS const unsigned char* vd_ = vb_ + (db) * 32 * AT_PITCH; dst[0] = *(const LAS bf16x8*)(vd_); dst[1] = *(const LAS bf16x8*)(vd_ + 16); \
        dst[2] = *(const LAS bf16x8*)(vd_ + 64); dst[3] = *(const LAS bf16x8*)(vd_ + 80); __builtin_amdgcn_sched_barrier(0); } while (0)
#define AT_PV(f, db) do { o[db] = __builtin_amdgcn_mfma_f32_32x32x16_bf16(f[0], pw0, o[db], 0, 0, 0); o[db] = __builtin_amdgcn_mfma_f32_32x32x16_bf16(f[1], pw1, o[db], 0, 0, 0); \
        o[db] = __builtin_amdgcn_mfma_f32_32x32x16_bf16(f[2], pw2_, o[db], 0, 0, 0); o[db] = __builtin_amdgcn_mfma_f32_32x32x16_bf16(f[3], pw3_, o[db], 0, 0, 0); __builtin_amdgcn_sched_barrier(0); } while (0)
#define AT_V2(dst, i, db, off) dst[i] = *(const LAS bf16x8*)(vb_ + (db) * 32 * AT_PITCH + (off))
#define AT_E4(b) do { _Pragma("unroll") for (int r = (b); r < (b) + 4; ++r) { p1[r] = __builtin_amdgcn_exp2f(p1[r]); ls_ += p1[r]; } } while (0)
#define AT_Y(t, STAGE_OP) do { \
          \
          \
        LAS const unsigned char* vb_ = lds + so + AT_V + r32 * AT_PITCH + hi * 32; \
        bf16x8 fa_[4], fb_[4]; float ls_ = 0.f; \
        AT_V2(fa_, 0, 0, 0); AT_V2(fa_, 1, 0, 16); AT_V2(fa_, 2, 1, 0); AT_V2(fa_, 3, 1, 16); __builtin_amdgcn_sched_barrier(0); \
        STAGE_OP; \
        AT_V2(fb_, 0, 2, 0); AT_V2(fb_, 1, 2, 16); AT_V2(fb_, 2, 3, 0); AT_V2(fb_, 3, 3, 16); __builtin_amdgcn_sched_barrier(0); \
        __builtin_amdgcn_s_setprio(1); o[0] = __builtin_amdgcn_mfma_f32_32x32x16_bf16(fa_[0], pw0, o[0], 0, 0, 0); o[1] = __builtin_amdgcn_mfma_f32_32x32x16_bf16(fa_[2], pw0, o[1], 0, 0, 0); __builtin_amdgcn_s_setprio(0); AT_E4(0); __builtin_amdgcn_sched_barrier(0); \
        __builtin_amdgcn_s_setprio(1); o[0] = __builtin_amdgcn_mfma_f32_32x32x16_bf16(fa_[1], pw1, o[0], 0, 0, 0); o[1] = __builtin_amdgcn_mfma_f32_32x32x16_bf16(fa_[3], pw1, o[1], 0, 0, 0); __builtin_amdgcn_s_setprio(0); AT_E4(4); __builtin_amdgcn_sched_barrier(0); \
        AT_V2(fa_, 0, 0, 64); AT_V2(fa_, 1, 0, 80); AT_V2(fa_, 2, 1, 64); AT_V2(fa_, 3, 1, 80); __builtin_amdgcn_sched_barrier(0); \
        __builtin_amdgcn_s_setprio(1); o[2] = __builtin_amdgcn_mfma_f32_32x32x16_bf16(fb_[0], pw0, o[2], 0, 0, 0); o[3] = __builtin_amdgcn_mfma_f32_32x32x16_bf16(fb_[2], pw0, o[3], 0, 0, 0); __builtin_amdgcn_s_setprio(0); AT_E4(8); __builtin_amdgcn_sched_barrier(0); \
        __builtin_amdgcn_s_setprio(1); o[2] = __builtin_amdgcn_mfma_f32_32x32x16_bf16(fb_[1], pw1, o[2], 0, 0, 0); o[3] = __builtin_amdgcn_mfma_f32_32x32x16_bf16(fb_[3], pw1, o[3], 0, 0, 0); __builtin_amdgcn_s_setprio(0); AT_E4(12); \
        l_run += ls_; \
        u32x4 c2_, d2_; \
        c2_.x = cvtpk(p1[0], p1[1]); c2_.y = cvtpk(p1[2], p1[3]); c2_.z = cvtpk(p1[4], p1[5]); c2_.w = cvtpk(p1[6], p1[7]); \
        d2_.x = cvtpk(p1[8], p1[9]); d2_.y = cvtpk(p1[10], p1[11]); d2_.z = cvtpk(p1[12], p1[13]); d2_.w = cvtpk(p1[14], p1[15]); \
        const bf16x8 pw2_ = __builtin_bit_cast(bf16x8, c2_), pw3_ = __builtin_bit_cast(bf16x8, d2_); __builtin_amdgcn_sched_barrier(0); \
        AT_V2(fb_, 0, 2, 64); AT_V2(fb_, 1, 2, 80); AT_V2(fb_, 2, 3, 64); AT_V2(fb_, 3, 3, 80); __builtin_amdgcn_sched_barrier(0); \
        __builtin_amdgcn_s_setprio(1); o[0] = __builtin_amdgcn_mfma_f32_32x32x16_bf16(fa_[0], pw2_, o[0], 0, 0, 0); o[1] = __builtin_amdgcn_mfma_f32_32x32x16_bf16(fa_[2], pw2_, o[1], 0, 0, 0); __builtin_amdgcn_s_setprio(0); \
        __builtin_amdgcn_s_setprio(1); o[0] = __builtin_amdgcn_mfma_f32_32x32x16_bf16(fa_[1], pw3_, o[0], 0, 0, 0); o[1] = __builtin_amdgcn_mfma_f32_32x32x16_bf16(fa_[3], pw3_, o[1], 0, 0, 0); __builtin_amdgcn_s_setprio(0); __builtin_amdgcn_sched_barrier(0); \
        __builtin_amdgcn_s_setprio(1); o[2] = __builtin_amdgcn_mfma_f32_32x32x16_bf16(fb_[0], pw2_, o[2], 0, 0, 0); o[3] = __builtin_amdgcn_mfma_f32_32x32x16_bf16(fb_[2], pw2_, o[3], 0, 0, 0); __builtin_amdgcn_s_setprio(0); \
        __builtin_amdgcn_s_setprio(1); o[2] = __builtin_amdgcn_mfma_f32_32x32x16_bf16(fb_[1], pw3_, o[2], 0, 0, 0); o[3] = __builtin_amdgcn_mfma_f32_32x32x16_bf16(fb_[3], pw3_, o[3], 0, 0, 0); __builtin_amdgcn_s_setprio(0); __builtin_amdgcn_sched_barrier(0); } while (0)
    int so = 0, s2 = 2;
    if (mp == 0) {
        for (int t = 0; t < NT; ++t) {
            AT_X(t, (void)0); AT_BAR();
            AT_Y(t, if (t + 2 < NT) AT_DMA(t + 2, s2)); if (t + 2 < NT) AT_BARV5(); else AT_BARV0();
            so = so == 2 * AT_STAGE ? 0 : so + AT_STAGE; s2 = s2 == 2 ? 0 : s2 + 1;
        }
        AT_BAR();
    } else {
        AT_BAR();
        for (int t = 0; t < NT; ++t) {
            AT_X(t, if (t + 2 < NT) AT_DMA(t + 2, s2)); if (t + 2 < NT) AT_BARV5(); else AT_BARV0();
            AT_Y(t, (void)0); AT_BAR();
            so = so == 2 * AT_STAGE ? 0 : so + AT_STAGE; s2 = s2 == 2 ? 0 : s2 + 1;
        }
    }
#undef AT_X
#undef AT_Y
#undef AT_VRD
#undef AT_PV
#undef AT_V2
#undef AT_E4
#undef AT_BAR
#undef AT_BARV5
#undef AT_BARV0
#undef AT_DMA
    l_run += __shfl_xor(l_run, 32);
    const float inv = 1.f / l_run;
    LAS float* X = (LAS float*)lds + g * 4096;
    if (mp == 1) { const float f = inv * lam;
#pragma unroll
        for (int d = 0; d < 4; ++d)
#pragma unroll
            for (int r = 0; r < 16; ++r) X[(d * 16 + r) * 64 + lane] = o[d][r] * f; }
    __syncthreads();
    if (mp == 0) {
        float ss = 0.f;
#pragma unroll
        for (int d = 0; d < 4; ++d)
#pragma unroll
            for (int r = 0; r < 16; ++r) { const float v = o[d][r] * inv - X[(d * 16 + r) * 64 + lane]; o[d][r] = v; ss += v * v; }
        ss += __shfl_xor(ss, 32);
        const float rs = __builtin_amdgcn_rsqf(ss * (1.f / 128.f) + EPS) * oscale;
        bf16_t* op = cat + (size_t)(tokbase + qpos) * DM + h * 128 + 4 * hi;
#pragma unroll
        for (int d = 0; d < 4; ++d)
#pragma unroll
            for (int rq = 0; rq < 4; ++rq) { const int dv = 32 * d + 8 * rq; const f32x4 gn = *(const f32x4*)(subln + dv + 4 * hi);
                u32x2 wv; wv.x = cvtpk(o[d][4 * rq] * rs * gn[0], o[d][4 * rq + 1] * rs * gn[1]); wv.y = cvtpk(o[d][4 * rq + 2] * rs * gn[2], o[d][4 * rq + 3] * rs * gn[3]);
                *(u32x2*)(op + dv) = wv; }
    }
    __syncthreads();
}

__device__ __forceinline__ void row_pass0(const float* xin, bf16_t* hrow, rss_t* rss, int lane) {
    float s2 = 0.f;
#pragma unroll
    for (int j = 0; j < 4; ++j) { const int c = 8 * (lane + 64 * j);
        const f32x4 a = *(const f32x4*)(xin + c), b = *(const f32x4*)(xin + c + 4);
        u32x4 w; w.x = cvtpk(a[0], a[1]); w.y = cvtpk(a[2], a[3]); w.z = cvtpk(b[0], b[1]); w.w = cvtpk(b[2], b[3]);
        *(u32x4*)(hrow + c) = w;
#pragma unroll
        for (int e = 0; e < 4; ++e) { const float lo = bflo(w[e]), hi = bfhi(w[e]); s2 += lo * lo + hi * hi; } }
    s2 = wave_sum(s2);
    if (lane == 0) *rss = (rss_t)(s2 * RSS_FX + 0.5f);
}

__device__ __forceinline__ void conv_job(const float* W, const float* gk, int ldw, int Krows, int n_begin, int ncols, bf16_t* WT, int row_off, int ilv, LAS float* scr, int gw, int NGW, int lane) {
    (void)scr;
    const int nblk = ncols / 64, nitems = (Krows / 32) * nblk;
    for (int it = gw; it < nitems; it += NGW) {
        const int kb = it / nblk, nb = it % nblk, k0 = 32 * kb, j = 64 * nb + lane;
        const float* wp = W + (size_t)k0 * ldw + n_begin + j;
        float v[32];
#pragma unroll
        for (int i = 0; i < 32; ++i) v[i] = wp[(size_t)i * ldw];
        if (gk) {
#pragma unroll
            for (int i = 0; i < 32; ++i) v[i] *= gk[k0 + i];
        }
        const int dr = row_off + (ilv < 0 ? j : ((j >> 7) * 256 + ilv * 128 + (j & 127)));
        bf16_t* dp = WT + (size_t)dr * Krows + k0;
#pragma unroll
        for (int c = 0; c < 4; ++c) { u32x4 o; o.x = cvtpk(v[8 * c], v[8 * c + 1]); o.y = cvtpk(v[8 * c + 2], v[8 * c + 3]); o.z = cvtpk(v[8 * c + 4], v[8 * c + 5]); o.w = cvtpk(v[8 * c + 6], v[8 * c + 7]);
            *(u32x4*)(dp + 8 * c) = o; }
    }
}

__device__ __forceinline__ int rel_bucket(int rel) {
    const int n = rel < 0 ? -rel : rel; int b;
    if (n < 8) b = n; else b = 8 + (n >= 12) + (n >= 16) + (n >= 23) + (n >= 32) + (n >= 46) + (n >= 64) + (n >= 91);
    return (rel > 0 ? 16 : 0) + b;
}


#define XB_TMO      128
#define XB_XCNT(j)  (256  + 64 * (j))
#define XB_XSUB(j)  (1280 + 64 * (j))
#define XB_XGEN(j)  (2304 + 64 * (j))
#define XB_TOP      3328
#define XB_TOPGEN   3392
#define XCD_BAR_WORDS 3456
#define XB_SPIN_CAP (1u << 22)
__device__ __forceinline__ unsigned xb_ld(unsigned* p)              { return __hip_atomic_load(p, __ATOMIC_RELAXED, __HIP_MEMORY_SCOPE_AGENT); }
__device__ __forceinline__ unsigned xb_add(unsigned* p, unsigned v) { return __hip_atomic_fetch_add(p, v, __ATOMIC_RELAXED, __HIP_MEMORY_SCOPE_AGENT); }
__device__ __forceinline__ unsigned xb_xcc_id() { return (unsigned)__builtin_amdgcn_s_getreg((3 << 11) | 20) & 0xFu; }
#define XB_SPIN(cond, bar) do { unsigned _sp = 0; while (cond) { __builtin_amdgcn_s_sleep(1); \
    if ((++_sp & 255u) == 0u) { if (xb_ld(&(bar)[XB_TMO])) break; if (_sp > XB_SPIN_CAP) { atomicAdd(&(bar)[XB_TMO], 1u); break; } } } } while (0)
__device__ __forceinline__ void xcd_barrier_complete(unsigned* bar, unsigned x, unsigned& nloc, unsigned& nx) {
    const unsigned G = gridDim.x * gridDim.y * gridDim.z;
    unsigned sum, cnt, mine, sp = 0u;
    for (;;) {
        sum = 0u; cnt = 0u; mine = 0u;
#pragma unroll
        for (unsigned j = 0; j < 16; ++j) { const unsigned c = xb_ld(&bar[XB_XCNT(j)]); sum += c; cnt += (c > 0u) ? 1u : 0u; mine = (j == x) ? c : mine; }
        if (sum == G) break;
        __builtin_amdgcn_s_sleep(1);
        if ((++sp & 255u) == 0u) { if (xb_ld(&bar[XB_TMO])) break; if (sp > XB_SPIN_CAP) { atomicAdd(&bar[XB_TMO], 1u); break; } }
    }
    nloc = mine > 0u ? mine : 1u; nx = cnt > 0u ? cnt : 1u;
}
__device__ __forceinline__ void xcd_barrier(unsigned* bar, volatile LAS unsigned* st) {
    asm volatile("s_waitcnt vmcnt(0)" ::: "memory");
    __syncthreads();
    if (threadIdx.x == 0) {
        const unsigned x = xb_xcc_id();
        __builtin_amdgcn_s_waitcnt(0);
        unsigned nloc = st[0], nx = st[1];
        if (nloc == 0u) { xcd_barrier_complete(bar, x, nloc, nx); st[0] = nloc; st[1] = nx; }
        const unsigned old = xb_add(&bar[XB_XSUB(x)], 1u);
        const unsigned gen = old / nloc;
        if (old + 1u == (gen + 1u) * nloc) {
            __builtin_amdgcn_fence(__ATOMIC_RELEASE, "agent");
            asm volatile("s_waitcnt vmcnt(0)" ::: "memory");
            const unsigned og = xb_add(&bar[XB_TOP], 1u);
            const unsigned tg = og / nx;
            if (og + 1u == (tg + 1u) * nx) xb_add(&bar[XB_TOPGEN], 1u);
            else XB_SPIN(xb_ld(&bar[XB_TOPGEN]) == tg, bar);
            __builtin_amdgcn_fence(__ATOMIC_ACQUIRE, "agent");
            xb_add(&bar[XB_XGEN(x)], 1u);
            asm volatile("s_waitcnt vmcnt(0)" ::: "memory");
        } else {
            XB_SPIN(xb_ld(&bar[XB_XGEN(x)]) == gen, bar);
            __builtin_amdgcn_fence(__ATOMIC_ACQUIRE, "agent");
            asm volatile("s_waitcnt vmcnt(0)" ::: "memory");
        }
    }
    __syncthreads();
}

struct Args { const float* in[22]; float* out; unsigned char* ws; int ph_lo, ph_hi; };
enum { I_XP = 0, I_XS, I_RELB, I_NPRE_MIX, I_NPOST_MIX, I_NPRE_FFN, I_NPOST_FFN, I_AB_WIN, I_AB_WOUT, I_LQ1, I_LK1, I_LQ2, I_LK2, I_SUBLN,
       I_C_WIN, I_C_CONV, I_C_WOUT, I_F_WG, I_F_WU, I_F_CONV, I_F_CONVB, I_F_WD };

__global__ void __launch_bounds__(512, 2) mk_fwd(Args args_unused) {
    extern __shared__ __attribute__((aligned(16))) unsigned char lds_raw[];
    typedef const __attribute__((address_space(4))) Args* KArgsP;
#define KARGS KArgsP A; { auto ka_ = __builtin_amdgcn_kernarg_segment_ptr(); asm volatile("" : "+s"(ka_)); A = (KArgsP)ka_; } \
    LAS unsigned char* lds = (LAS unsigned char*)lds_raw; \
    int tid = threadIdx.x; asm volatile("" : "+v"(tid)); const int lane = tid & 63, wave = __builtin_amdgcn_readfirstlane(tid >> 6); \
    const int G = gridDim.x, bx = blockIdx.x; const int vcu = (G % 8 == 0) ? (bx % 8) * (G / 8) + bx / 8 : bx; const int gw = vcu * 8 + wave, NGW = G * 8; \
    unsigned char* ws = A->ws; float* xres = A->out; bf16_t* H = (bf16_t*)(ws + WS_H); unsigned char* WBM = ws + WS_WB; unsigned char* WBF = ws + WS_WB1; unsigned char* SCR = ws + WS_SCR; \
    float* biasT = (float*)(ws + WS_CTL); LAS float* scr = (LAS float*)(lds + wave * 16384); \
    (void)lane; (void)gw; (void)NGW; (void)xres; (void)H; (void)WBM; (void)WBF; (void)SCR; (void)biasT; (void)scr; (void)vcu; (void)bx
    int lo, hi;
    { KArgsP A0; { auto ka_ = __builtin_amdgcn_kernarg_segment_ptr(); A0 = (KArgsP)ka_; } lo = A0->ph_lo; hi = A0->ph_hi; }
    if (lo < 0) cg::this_grid().sync();
    { volatile LAS unsigned* st_ = (volatile LAS unsigned*)((LAS unsigned char*)lds_raw + LDS_MISC); if (threadIdx.x < 2) st_[threadIdx.x] = 0u; __syncthreads();
      if (hi - lo > 1 && threadIdx.x == 0) { KArgsP A1; { auto ka_ = __builtin_amdgcn_kernarg_segment_ptr(); A1 = (KArgsP)ka_; } (void)xb_add((unsigned*)(A1->ws + WS_BAR) + XB_XCNT(xb_xcc_id()), 1u); } }
    int ph = 0;
#define PH_ON (ph >= lo && ph < hi)
#define PH_END do { if (ph >= lo && ph + 1 < hi) { unsigned* bar_; { auto ka_ = __builtin_amdgcn_kernarg_segment_ptr(); asm volatile("" : "+s"(ka_)); bar_ = (unsigned*)(((KArgsP)ka_)->ws + WS_BAR); } \
        xcd_barrier(bar_, (volatile LAS unsigned*)((LAS unsigned char*)lds_raw + LDS_MISC)); } ++ph; } while (0)

#define CONV_AB(j) do { const float* win_ = A->in[I_AB_WIN] + (size_t)(j) * DM * 4096; const float* wout_ = A->in[I_AB_WOUT] + (size_t)(j) * DM * DM; \
        conv_job(win_, A->in[I_NPRE_MIX] + 2 * (j) * DM, 4096, DM, 0, 2048, (bf16_t*)(WBM + WB_QKF), 0, -1, scr, gw, NGW, lane); \
        conv_job(win_, A->in[I_NPRE_MIX] + 2 * (j) * DM, 4096, DM, 3072, 1024, (bf16_t*)(WBM + WB_QKF), 2048, -1, scr, gw, NGW, lane); \
        conv_job(win_, A->in[I_NPRE_MIX] + 2 * (j) * DM, 4096, DM, 2048, 1024, (bf16_t*)(WBM + WB_V), 0, -1, scr, gw, NGW, lane); \
        conv_job(wout_, nullptr, DM, DM, 0, DM, (bf16_t*)(WBM + WB_OUT), 0, -1, scr, gw, NGW, lane); } while (0)
#define CONV_C(j) do { const float* win_ = A->in[I_C_WIN] + (size_t)(j) * DM * 6144; const float* wout_ = A->in[I_C_WOUT] + (size_t)(j) * DM * DM; \
        conv_job(win_, A->in[I_NPRE_MIX] + (2 * (j) + 1) * DM, 6144, DM, 0, 2048, (bf16_t*)(WBM + WB_CB), 0, -1, scr, gw, NGW, lane); \
        conv_job(win_, A->in[I_NPRE_MIX] + (2 * (j) + 1) * DM, 6144, DM, 2048, 2048, (bf16_t*)(WBM + WB_CX), 0, 0, scr, gw, NGW, lane); \
        conv_job(win_, A->in[I_NPRE_MIX] + (2 * (j) + 1) * DM, 6144, DM, 4096, 2048, (bf16_t*)(WBM + WB_CX), 0, 1, scr, gw, NGW, lane); \
        conv_job(wout_, nullptr, DM, DM, 0, DM, (bf16_t*)(WBM + WB_COUT), 0, -1, scr, gw, NGW, lane); } while (0)
#define CONV_FFN(i) do { \
        conv_job(A->in[I_F_WG] + (size_t)(i) * DM * DFF, A->in[I_NPRE_FFN] + (i) * DM, DFF, DM, 0, DFF, (bf16_t*)(WBF + WB_G), 0, -1, scr, gw, NGW, lane); \
        conv_job(A->in[I_F_WU] + (size_t)(i) * DM * DFF, A->in[I_NPRE_FFN] + (i) * DM, DFF, DM, 0, DFF, (bf16_t*)(WBF + WB_U), 0, -1, scr, gw, NGW, lane); \
        conv_job(A->in[I_F_WD] + (size_t)(i) * DFF * DM, nullptr, DM, DFF, 0, DM, (bf16_t*)(WBF + WB_D), 0, -1, scr, gw, NGW, lane); } while (0)

#define FUSED_OUT(Aptr, Bptr, KK, q_, gpost_, last_, rin_) do { \
        __syncthreads(); \
        pg8::ProbPanel P{(const char*)(Aptr), (const char*)(Bptr), (KK), (KK), (KK), bx}; \
        unsigned* cb_ = (unsigned*)(ws + WS_CNT) + (size_t)(q_) * 2 * 96 * 16; \
        pg8::EpiNormRes E{H, (last_) ? xres : (float*)nullptr, (gpost_), (rss_t*)(ws + WS_RSS) + (size_t)((q_) + 1 < 8 ? (q_) + 1 : 0) * NTOK, (rin_), (float*)(ws + WS_X1), cb_, (unsigned*)(ws + WS_BAR) + XB_TMO, lds + LDS_EPI}; \
        pg8::gemm_phase(lds, P, E); } while (0)
    if (PH_ON) { KARGS;
        for (int m = gw; m < NTOK; m += NGW) {
            const float* xin = m < NTOK_P ? A->in[I_XP] + (size_t)m * DM : A->in[I_XS] + (size_t)(m - NTOK_P) * DM;
            row_pass0(xin, H + (size_t)m * DM, (rss_t*)(ws + WS_RSS) + m, lane);
        }
        CONV_AB(0);
        if (bx == 0 && tid < 2) { const int jj = tid; float d1 = 0.f, d2 = 0.f;
            for (int i = 0; i < 64; ++i) { d1 += A->in[I_LQ1][jj * 64 + i] * A->in[I_LK1][jj * 64 + i]; d2 += A->in[I_LQ2][jj * 64 + i] * A->in[I_LK2][jj * 64 + i]; }
            const float li = 0.8f - 0.6f * expf(-0.3f * (float)(2 * jj));
            biasT[8 * 260 + 2 * jj] = expf(d1) - expf(d2) + li; biasT[8 * 260 + 2 * jj + 1] = li; }
        for (int i = bx * 512 + tid; i < 8 * 257; i += G * 512) { const int h = i / 257, idx = i % 257; biasT[h * 260 + idx] = A->in[I_RELB][rel_bucket(idx - 128) * 8 + h] * LOG2E; }
        { bf16_t* dc = (bf16_t*)(ws + WS_DFTC);
          for (int i = bx * 512 + tid; i < 512 * 256 / 8; i += G * 512) { const int r = i / 32, c0 = (i % 32) * 8, cp = r & 255; float v[8];
#pragma unroll
              for (int e = 0; e < 8; ++e) { const float ph_ = (float)((cp * (c0 + e)) & 255) * (1.f / 256.f); v[e] = (r >> 8 ? __builtin_amdgcn_sinf(ph_) : __builtin_amdgcn_cosf(ph_)) * 0.0625f; }
              u32x4 w; w.x = cvtpk(v[0], v[1]); w.y = cvtpk(v[2], v[3]); w.z = cvtpk(v[4], v[5]); w.w = cvtpk(v[6], v[7]); *(u32x4*)(dc + (size_t)r * 256 + c0) = w; } }
#pragma unroll 1
        for (int which = 0; which < 2; ++which) {
            const int S = which ? SEQ_S : SEQ_P; bf16_t* cs = (bf16_t*)(ws + (which ? WS_CS2 : WS_CS4)); const float nrm = which ? 0.022097086912079608f : 0.015625f, invS = 1.f / (float)S;
            const int per_row = 2 * S / 8, total = S * per_row;
            for (int i = bx * 512 + tid; i < total; i += G * 512) { const int r = i / per_row, k0 = (i % per_row) * 8; const bool sn = k0 >= S; const int kk = sn ? k0 - S : k0; float v[8];
#pragma unroll
                for (int e = 0; e < 8; ++e) { const float ph_ = (float)((r * (kk + e)) & (S - 1)) * invS; v[e] = sn ? -__builtin_amdgcn_sinf(ph_) * nrm : __builtin_amdgcn_cosf(ph_) * nrm; }
                u32x4 w; w.x = cvtpk(v[0], v[1]); w.y = cvtpk(v[2], v[3]); w.z = cvtpk(v[4], v[5]); w.w = cvtpk(v[6], v[7]); *(u32x4*)(cs + (size_t)r * 2 * S + k0) = w; }
        }
    }
    PH_END;

#pragma unroll 1
    for (int layer = 0; layer < NLAYER; ++layer) {
        const int j = layer >> 1;
        if ((layer & 1) == 0) {
#define AB_PTRS bf16_t* zqkf = (bf16_t*)(SCR + SC_ZQKF); bf16_t* vt = (bf16_t*)(SCR + SC_VT); bf16_t* cat = (bf16_t*)(SCR + SC_CAT); bf16_t* yt = (bf16_t*)(SCR + SC_YT); \
        bf16_t* Mbuf = (bf16_t*)(SCR + SC_ABM); (void)zqkf; (void)vt; (void)cat; (void)yt; (void)Mbuf
            if (PH_ON) { KARGS; AB_PTRS;
                pg8::ProbAB1 P{(const char*)H, (const char*)(WBM + WB_QKF), (const char*)(WBM + WB_V), DM, DM, DM, G, bx};
                pg8::EpiStore<pg8::AddrAB1> E{{zqkf, vt, (const rss_t*)(ws + WS_RSS) + (size_t)(2 * layer) * NTOK}};
                pg8::gemm_phase(lds, P, E);
            }
            PH_END;
            if (PH_ON) { KARGS; AB_PTRS;
                pg8::ProbF1 P{(const char*)(ws + WS_DFTC), (const char*)(zqkf + 2048), 256, 256, 3072, G, bx};
                pg8::EpiStore<pg8::AddrF1> E{{yt}};
                pg8::gemm_phase(lds, P, E);
            }
            PH_END;
            if (PH_ON) { KARGS; AB_PTRS;
                const float lam = biasT[8 * 260 + 2 * j], lam_init = biasT[8 * 260 + 2 * j + 1];
                const float* subln = A->in[I_SUBLN] + j * 128;
#ifdef PROBE_ATTN2
                for (int rep_ = 0; rep_ < 2; ++rep_) {
#else
                {
#endif
                for (int u = vcu; u < 512; u += G) { const int bh = u >> 5, qb = u & 31;
                    attn_unit(lds, zqkf, vt, cat, biasT, subln, lam, 1.f - lam_init, (bh >> 3) * SEQ_P, SEQ_P, bh & 7, qb * 128); }
                for (int u = vcu; u < 1024; u += G) { const int bh = u >> 4, qb = u & 15;
                    attn_unit(lds, zqkf, vt, cat, biasT, subln, lam, 1.f - lam_init, NTOK_P + (bh >> 3) * SEQ_S, SEQ_S, bh & 7, qb * 128); }
                }
                {
                    int firstP, cntP, firstS, cntS;
                    if (G == 256) { firstP = vcu; cntP = vcu < 128 ? 1 : 0; firstS = (vcu - 128) * 2; cntS = vcu >= 128 ? 2 : 0; }
                    else { const int per = (128 + G - 1) / G; firstP = vcu * per; cntP = firstP >= 128 ? 0 : (128 - firstP < per ? 128 - firstP : per);
                           const int per2 = (256 + G - 1) / G; firstS = vcu * per2; cntS = firstS >= 256 ? 0 : (256 - firstS < per2 ? 256 - firstS : per2); }
                    pg8::ProbF2 PP{(const char*)(ws + WS_CS4), (const char*)yt, 2 * SEQ_P, 2 * SEQ_P, 2 * 2 * SEQ_P, 2, 16, firstP, cntP};
                    pg8::EpiStore<pg8::AddrF2> EP{{cat, 0, SEQ_P}};
                    pg8::gemm_phase(lds, PP, EP);
                    pg8::ProbF2 PS{(const char*)(ws + WS_CS2), (const char*)yt + YT_S_OFF, 2 * SEQ_S, 2 * SEQ_S, 8 * 2 * SEQ_S, 8, 8, firstS, cntS};
                    pg8::EpiStore<pg8::AddrF2> ES{{cat, NTOK_P, SEQ_S}};
                    pg8::gemm_phase(lds, PS, ES);
                }
            }
            PH_END;
            if (PH_ON) { KARGS; AB_PTRS;
                CONV_FFN(layer);
                FUSED_OUT(cat, WBM + WB_OUT, DM, 2 * layer, A->in[I_NPOST_MIX] + layer * DM, false, (const rss_t*)nullptr);
            }
            PH_END;
        } else {
#define C_PTRS bf16_t* pbuf = (bf16_t*)(SCR + SC_P); bf16_t* ubuf = (bf16_t*)(SCR + SC_U); bf16_t* Mbuf = (bf16_t*)(SCR + SC_CM); (void)pbuf; (void)ubuf; (void)Mbuf
            if (PH_ON) { KARGS; C_PTRS;
                pg8::ProbSimple P{(const char*)H, (const char*)(WBM + WB_CX), DM, DM, DM, NTOK / 256, 4096 / 256, G, bx};
                pg8::EpiMulHalves E{pbuf, DM, (const rss_t*)(ws + WS_RSS) + (size_t)(2 * layer) * NTOK};
                pg8::gemm_phase(lds, P, E);
            }
            PH_END;
            if (PH_ON) { KARGS; C_PTRS;
                pg8::ProbSimple P{(const char*)H, (const char*)(WBM + WB_CB), DM, DM, DM, NTOK / 256, DM / 256, G, bx};
                pg8::EpiConvMul<false> E{pbuf, ubuf, A->in[I_C_CONV] + (size_t)j * 3 * DM, nullptr, DM};
                pg8::gemm_phase(lds, P, E);
            }
            PH_END;
            if (PH_ON) { KARGS; C_PTRS;
                CONV_FFN(layer);
                FUSED_OUT(ubuf, WBM + WB_COUT, DM, 2 * layer, A->in[I_NPOST_MIX] + layer * DM, false, (const rss_t*)(ws + WS_RSS) + (size_t)(2 * layer) * NTOK);
            }
            PH_END;
        }
#define F_PTRS bf16_t* gate = (bf16_t*)(SCR + SC_GATE); bf16_t* act = (bf16_t*)(SCR + SC_ACT); bf16_t* fm = (bf16_t*)(SCR + SC_FM); (void)gate; (void)act; (void)fm
        if (PH_ON) { KARGS; F_PTRS;
            bf16_t* upraw = (bf16_t*)(WBM + 34 * MiB);
            pg8::ProbF1G P{(const char*)H, (const char*)(WBF + WB_G), (const char*)(WBF + WB_U), DM, DM, DM, G, bx};
            pg8::EpiStore<pg8::AddrF1G> E{{gate, upraw, (const rss_t*)(ws + WS_RSS) + (size_t)(2 * layer + 1) * NTOK}};
            pg8::gemm_phase(lds, P, E);
        }
        PH_END;
        if (PH_ON) { KARGS; F_PTRS;
            pg8::ProbSimple P{(const char*)H, (const char*)(WBF + WB_U), DM, DM, DM, NTOK / 256, 20, G, bx};
            pg8::EpiConvMul<true> E{gate, act, A->in[I_F_CONV] + (size_t)layer * 3 * DFF, A->in[I_F_CONVB] + (size_t)layer * DFF, DFF};
            pg8::gemm_phase(lds, P, E);
            const int nfull = (96 * 20) / G, rem = 96 * 20 - nfull * G;
            if (bx >= rem) {
                const bf16_t* upraw = (const bf16_t*)(WBM + 34 * MiB);
                const float* cw = A->in[I_F_CONV] + (size_t)layer * 3 * DFF; const float* cb = A->in[I_F_CONVB] + (size_t)layer * DFF;
                const int nth = (G - rem) * 512, t0 = (bx - rem) * 512 + tid;
                for (int idx = t0; idx < NTOK * 64; idx += nth) {
                    const int row = idx >> 6, c0 = 5120 + (idx & 63) * 8;
                    const int smask = row < NTOK_P ? (SEQ_P - 1) : (SEQ_S - 1);
                    const bool hp = (row & smask) != 0, hn = (row & smask) != smask;
                    const bf16_t* sp = gate + (size_t)row * DFF + c0;
                    const u32x4 cu = *(const u32x4*)sp; u32x4 pv = *(const u32x4*)(hp ? sp - DFF : sp), nx = *(const u32x4*)(hn ? sp + DFF : sp);
                    if (!hp) pv = (u32x4){0u, 0u, 0u, 0u}; if (!hn) nx = (u32x4){0u, 0u, 0u, 0u};
                    const u32x4 up = *(const u32x4*)(upraw + (size_t)row * 512 + (c0 - 5120));
                    float r[8];
#pragma unroll
                    for (int e = 0; e < 4; ++e) {
                        const f32x2_t w0 = *(const f32x2_t*)(cw + c0 + 2 * e), w1 = *(const f32x2_t*)(cw + DFF + c0 + 2 * e), w2 = *(const f32x2_t*)(cw + 2 * DFF + c0 + 2 * e), bb = *(const f32x2_t*)(cb + c0 + 2 * e);
                        float g0 = w0[0] * bflo(pv[e]) + w1[0] * bflo(cu[e]) + w2[0] * bflo(nx[e]) + bb[0];
                        float g1 = w0[1] * bfhi(pv[e]) + w1[1] * bfhi(cu[e]) + w2[1] * bfhi(nx[e]) + bb[1];
                        g0 = g0 * __builtin_amdgcn_rcpf(1.f + __builtin_amdgcn_exp2f(-g0 * LOG2E)); g1 = g1 * __builtin_amdgcn_rcpf(1.f + __builtin_amdgcn_exp2f(-g1 * LOG2E));
                        r[2 * e] = g0 * bflo(up[e]); r[2 * e + 1] = g1 * bfhi(up[e]); }
                    u32x4 w; w.x = cvtpk(r[0], r[1]); w.y = cvtpk(r[2], r[3]); w.z = cvtpk(r[4], r[5]); w.w = cvtpk(r[6], r[7]);
                    *(u32x4*)(act + (size_t)row * DFF + c0) = w;
                }
            }
        }
        PH_END;
        if (PH_ON) { KARGS; F_PTRS;
            const bool lastl = layer == NLAYER - 1;
            if (!lastl) { if (((layer + 1) & 1) == 0) CONV_AB((layer + 1) >> 1); else CONV_C((layer + 1) >> 1); }
            FUSED_OUT(act, WBF + WB_D, DFF, 2 * layer + 1, A->in[I_NPOST_FFN] + layer * DM, lastl, (const rss_t*)(ws + WS_RSS) + (size_t)(2 * layer + 1) * NTOK);
        }
        PH_END;
    }
}
constexpr int N_PHASES = 1 + 2 * (4 + 3) + 2 * (3 + 3);

extern "C" void kernel_launch(void* const* d_in, const int* in_sizes, int n_in, void* d_out, int out_size, void* d_ws, size_t ws_size, hipStream_t stream) {
    static int grid = 0;
    if (grid == 0) {
        if (n_in != 22 || out_size != NTOK * DM || ws_size < WS_END) { fprintf(stderr, "kernel_launch: unexpected shapes (n_in %d out %d ws %zu)\n", n_in, out_size, ws_size); grid = -1; return; }
        int dev = 0, cus = 0, per_cu = 0;
        hipGetDevice(&dev); hipDeviceGetAttribute(&cus, hipDeviceAttributeMultiprocessorCount, dev);
        if (hipFuncSetAttribute((const void*)mk_fwd, hipFuncAttributeMaxDynamicSharedMemorySize, LDS_BYTES) != hipSuccess) { fprintf(stderr, "kernel_launch: hipFuncSetAttribute failed\n"); grid = -1; return; }
        if (hipOccupancyMaxActiveBlocksPerMultiprocessor(&per_cu, (const void*)mk_fwd, 512, LDS_BYTES) != hipSuccess || per_cu < 1) { fprintf(stderr, "kernel_launch: occupancy query says %d\n", per_cu); per_cu = 1; }
        (void)hipGetLastError();
        grid = cus;
        if (grid != 256) { fprintf(stderr, "kernel_launch: built for a 256-CU device (got %d)\n", cus); grid = -1; return; }
    }
    if (grid < 0) return;
    Args a{};
    for (int i = 0; i < 22; ++i) a.in[i] = (const float*)d_in[i];
    a.out = (float*)d_out; a.ws = (unsigned char*)d_ws;
#if MK_ONE_LAUNCH
    if (hipMemsetAsync((char*)d_ws + ZERO_OFF, 0, ZERO_BYTES, stream) != hipSuccess) { fprintf(stderr, "kernel_launch: memset failed\n"); return; }
    static_assert(WS_RSS + RSS_BYTES <= ZERO_OFF + ZERO_BYTES && WS_RSS >= ZERO_OFF, "row sums inside the zeroed region");
    a.ph_lo = 0; a.ph_hi = N_PHASES;
    void* params[] = {&a};
    hipError_t e = hipLaunchCooperativeKernel((const void*)mk_fwd, dim3(grid), dim3(512), params, LDS_BYTES, stream);
    if (e != hipSuccess) fprintf(stderr, "kernel_launch: cooperative launch failed: %s (grid %d)\n", hipGetErrorString(e), grid);
#else
    for (int p = 0; p < N_PHASES; ++p) {
        a.ph_lo = p; a.ph_hi = p + 1;
        hipLaunchKernelGGL(mk_fwd, dim3(grid), dim3(512), LDS_BYTES, stream, a);
    }
#endif
}
```
